# Optimizing an MI355X kernel written in HIP

```python
import math
import jax
import jax.numpy as jnp
from jax import lax
import numpy as np

D_MODEL = 1024
BATCH = 4
SEQ = 4096
DEPTH = 2

EPS = 1e-6
ROPE_THETA = 500000.0
Q_BLOCK = 128
D_FF = 2816
NEG_BIG = -1e30
FORCE_SCORE = 1e9

A_HEADS = 6
A_Q_RANK = 192
A_KV_RANK = 128
A_NOPE = 64
A_ROPE = 32
A_V = 64

B_HEADS = 6
B_KV_GROUPS = 2
B_HPG = B_HEADS // B_KV_GROUPS
B_DH = 64
B_ROT = B_DH // 4
CMP_LEN = 32
CMP_STRIDE = 16
SLC_LEN = 64
SLC_TOPN = 16
WINDOW = 512

C_HEADS = 4
C_DH = 32
C_ROT = C_DH // 4

MIX_WIDTH = A_HEADS * A_V + B_HEADS * B_DH + C_HEADS * 2 * C_DH
A_COLS = A_Q_RANK + A_KV_RANK + A_ROPE
B_COLS = B_HEADS * B_DH + 6 * B_KV_GROUPS * B_DH + 3 * B_HEADS
C_COLS = 3 * C_HEADS * 2 * C_DH
IN_COLS = A_COLS + B_COLS + C_COLS

kernel_name = 'hybrid_mla_nsa_diffattn_macaron'


def rmsnorm(x, g):
    xf = x.astype(jnp.float32)
    y = xf * lax.rsqrt(jnp.mean(xf * xf, axis=-1, keepdims=True) + EPS)
    return (y * g.astype(jnp.float32)).astype(x.dtype)


def rope_tables(positions, rot_dim):
    inv_freq = 1.0 / (ROPE_THETA ** (jnp.arange(0, rot_dim, 2, dtype=jnp.float32) / rot_dim))
    ang = positions.astype(jnp.float32)[..., None] * inv_freq
    return (jnp.cos(ang), jnp.sin(ang))


def apply_rope(x, cs):
    cos, sin = cs
    B, T, r2 = cos.shape
    shape = (B,) + (1,) * (x.ndim - 3) + (T, r2)
    cos = cos.reshape(shape)
    sin = sin.reshape(shape)
    xf = x.astype(jnp.float32)
    x1, x2 = xf[..., :r2], xf[..., r2:]
    return jnp.concatenate([x1 * cos - x2 * sin, x1 * sin + x2 * cos], axis=-1).astype(x.dtype)


def partial_rope(x, cs):
    r = 2 * cs[0].shape[-1]
    return jnp.concatenate([apply_rope(x[..., :r], cs), x[..., r:]], axis=-1)


def swiglu(x, wg, wu, wd):
    return (jax.nn.silu(x @ wg) * (x @ wu)) @ wd


def causal_block_attention(q, k, v, scale):
    B, H, T, dk = q.shape
    nb = T // Q_BLOCK
    q_blocks = jnp.moveaxis(q.reshape(B, H, nb, Q_BLOCK, dk), 2, 0)
    kpos = jnp.arange(T)

    def one_block(args):
        qi, i = args
        s = jnp.einsum('bhqd,bhkd->bhqk', qi, k, preferred_element_type=jnp.float32) * scale
        qpos = i * Q_BLOCK + jnp.arange(Q_BLOCK)
        s = jnp.where(kpos[None, :] <= qpos[:, None], s, -jnp.inf)
        p = jax.nn.softmax(s, axis=-1)
        return jnp.einsum('bhqk,bhkd->bhqd', p.astype(v.dtype), v)

    o = lax.map(one_block, (q_blocks, jnp.arange(nb)))
    return jnp.moveaxis(o, 0, 2).reshape(B, H, T, v.shape[-1])


def mla_mixer(h, cs_a, q_norm, kv_norm, w_uq, w_ukv):
    B, T, _ = h.shape
    c_q, c_kv, k_pe = jnp.split(h, [A_Q_RANK, A_Q_RANK + A_KV_RANK], axis=-1)
    q = (rmsnorm(c_q, q_norm) @ w_uq).reshape(B, T, A_HEADS, A_NOPE + A_ROPE).transpose(0, 2, 1, 3)
    kv = (rmsnorm(c_kv, kv_norm) @ w_ukv).reshape(B, T, A_HEADS, A_NOPE + A_V).transpose(0, 2, 1, 3)
    q = jnp.concatenate([q[..., :A_NOPE], apply_rope(q[..., A_NOPE:], cs_a)], axis=-1)
    k_pe = apply_rope(k_pe[:, None], cs_a)
    k = jnp.concatenate([kv[..., :A_NOPE], jnp.broadcast_to(k_pe, (B, A_HEADS, T, A_ROPE))], axis=-1)
    v = kv[..., A_NOPE:]
    o = causal_block_attention(q, k, v, (A_NOPE + A_ROPE) ** -0.5)
    return o.transpose(0, 2, 1, 3).reshape(B, T, A_HEADS * A_V)


def nsa_mixer(h, cs_b, pe_k, pe_v, phi_k1, phi_k2, phi_v1, phi_v2):
    B, T, _ = h.shape
    G, Hg, DH = B_KV_GROUPS, B_HPG, B_DH
    qw, kvw = B_HEADS * DH, G * DH
    offs = [qw + j * kvw for j in range(7)]
    q, kc, vc, ks, vs, kw, vw, gate_logits = jnp.split(h, offs, axis=-1)

    def split_kv(t):
        return t.reshape(B, T, G, DH).transpose(0, 2, 1, 3)

    q = partial_rope(q.reshape(B, T, G, Hg, DH).transpose(0, 2, 3, 1, 4), cs_b)
    kc, ks, kw = [partial_rope(split_kv(t), cs_b) for t in (kc, ks, kw)]
    vc, vs, vw = [split_kv(t) for t in (vc, vs, vw)]
    scale = DH ** -0.5
    tpos = jnp.arange(T)
    nb = T // Q_BLOCK

    n_cmp = (T - CMP_LEN) // CMP_STRIDE + 1
    cmp_idx = jnp.arange(n_cmp)[:, None] * CMP_STRIDE + jnp.arange(CMP_LEN)[None, :]

    def compress(t, pe, w1, w2):
        blk = (t[:, :, cmp_idx] + pe).reshape(B, G, n_cmp, CMP_LEN * DH)
        return jax.nn.silu(blk @ w1) @ w2

    k_cmp = compress(kc, pe_k, phi_k1, phi_k2)
    v_cmp = compress(vc, pe_v, phi_v1, phi_v2)
    s_cmp = jnp.einsum('bghtd,bgcd->bghtc', q, k_cmp, preferred_element_type=jnp.float32) * scale
    cmp_mask = cmp_idx[:, -1][None, :] <= tpos[:, None]
    p_cmp = jax.nn.softmax(jnp.where(cmp_mask, s_cmp, NEG_BIG), axis=-1) * cmp_mask
    o_cmp = jnp.einsum('bghtc,bgcd->bghtd', p_cmp.astype(v_cmp.dtype), v_cmp)

    n_slc = T // SLC_LEN
    top_n = min(SLC_TOPN, n_slc)
    blk_start = jnp.arange(n_slc) * SLC_LEN
    overlap = ((cmp_idx[:, 0][:, None] < blk_start[None, :] + SLC_LEN)
               & (cmp_idx[:, -1][:, None] >= blk_start[None, :])).astype(jnp.float32)
    imp = jnp.einsum('bghtc,cm->bgtm', p_cmp, overlap)
    cur = (tpos // SLC_LEN)[:, None]
    m = jnp.arange(n_slc)[None, :]
    forced = (m == 0) | (m == cur) | (m == cur - 1)
    score = jnp.where(forced, FORCE_SCORE, jnp.where(m <= cur, imp, -1.0))
    sel = lax.top_k(score, top_n)[1]

    ks_blk = ks.reshape(B, G, n_slc, SLC_LEN, DH)
    vs_blk = vs.reshape(B, G, n_slc, SLC_LEN, DH)
    q_blocks = jnp.moveaxis(q.reshape(B, G, Hg, nb, Q_BLOCK, DH), 3, 0)
    sel_blocks = jnp.moveaxis(sel.reshape(B, G, nb, Q_BLOCK, top_n), 2, 0)
    gather_blocks = jax.vmap(jax.vmap(lambda blocks, ids: blocks[ids]))

    def slc_block(args):
        qi, si, i = args
        kg = gather_blocks(ks_blk, si).reshape(B, G, Q_BLOCK, top_n * SLC_LEN, DH)
        vg = gather_blocks(vs_blk, si).reshape(B, G, Q_BLOCK, top_n * SLC_LEN, DH)
        kpos = (si[..., None] * SLC_LEN + jnp.arange(SLC_LEN)).reshape(B, G, Q_BLOCK, top_n * SLC_LEN)
        qpos = i * Q_BLOCK + jnp.arange(Q_BLOCK)
        valid = kpos <= qpos[:, None]
        s = jnp.einsum('bghqd,bgqkd->bghqk', qi, kg, preferred_element_type=jnp.float32) * scale
        p = jax.nn.softmax(jnp.where(valid[:, :, None], s, -jnp.inf), axis=-1)
        return jnp.einsum('bghqk,bgqkd->bghqd', p.astype(vg.dtype), vg)

    o_slc = lax.map(slc_block, (q_blocks, sel_blocks, jnp.arange(nb)))
    o_slc = jnp.moveaxis(o_slc, 0, 3).reshape(B, G, Hg, T, DH)

    kw_pad = jnp.pad(kw, ((0, 0), (0, 0), (WINDOW, 0), (0, 0)))
    vw_pad = jnp.pad(vw, ((0, 0), (0, 0), (WINDOW, 0), (0, 0)))
    band = jnp.arange(nb)[:, None] * Q_BLOCK + jnp.arange(WINDOW + Q_BLOCK)[None, :]
    kband = kw_pad[:, :, band]
    vband = vw_pad[:, :, band]
    kpos_w = band - WINDOW
    qpos_w = tpos.reshape(nb, Q_BLOCK)
    dist = qpos_w[:, :, None] - kpos_w[:, None, :]
    wmask = (dist >= 0) & (dist < WINDOW) & (kpos_w[:, None, :] >= 0)
    qwb = q.reshape(B, G, Hg, nb, Q_BLOCK, DH)
    s_w = jnp.einsum('bghnqd,bgnkd->bghnqk', qwb, kband, preferred_element_type=jnp.float32) * scale
    p_w = jax.nn.softmax(jnp.where(wmask, s_w, -jnp.inf), axis=-1)
    o_win = jnp.einsum('bghnqk,bgnkd->bghnqd', p_w.astype(vband.dtype), vband).reshape(B, G, Hg, T, DH)

    g = jax.nn.sigmoid(gate_logits.astype(jnp.float32)).reshape(B, T, G, Hg, 3)
    g = g.transpose(0, 2, 3, 1, 4).astype(q.dtype)
    o = g[..., 0:1] * o_cmp + g[..., 1:2] * o_slc + g[..., 2:3] * o_win
    return o.transpose(0, 3, 1, 2, 4).reshape(B, T, B_HEADS * DH)


def diff_mixer(h, cs_c, lq1, lk1, lq2, lk2, sub_norm, layer_idx):
    B, T, _ = h.shape
    q, k, v = jnp.split(h, 3, axis=-1)
    q = partial_rope(q.reshape(B, T, C_HEADS, 2, C_DH).transpose(0, 2, 3, 1, 4), cs_c)
    k = partial_rope(k.reshape(B, T, C_HEADS, 2, C_DH).transpose(0, 2, 3, 1, 4), cs_c)
    v = v.reshape(B, T, C_HEADS, 2 * C_DH).transpose(0, 2, 1, 3)
    lam_init = 0.8 - 0.6 * math.exp(-0.3 * layer_idx)
    f32 = jnp.float32
    lam = (jnp.exp(jnp.sum(lq1.astype(f32) * lk1.astype(f32)))
           - jnp.exp(jnp.sum(lq2.astype(f32) * lk2.astype(f32))) + lam_init)
    scale = C_DH ** -0.5
    o1 = causal_block_attention(q[:, :, 0], k[:, :, 0], v, scale)
    o2 = causal_block_attention(q[:, :, 1], k[:, :, 1], v, scale)
    o = o1.astype(f32) - lam * o2.astype(f32)
    o = (rmsnorm(o, sub_norm) * (1.0 - lam_init)).astype(h.dtype)
    return o.transpose(0, 2, 1, 3).reshape(B, T, C_HEADS * 2 * C_DH)


def setup_inputs(seed: int = 0) -> dict:
    key = jax.random.key(seed)
    keys = iter(jax.random.split(key, 40))
    f32 = jnp.float32
    L = DEPTH

    def nrm(shape, fan_in):
        return jax.random.normal(next(keys), shape, f32) * (fan_in ** -0.5)

    def gain(shape):
        return 1.0 + 0.02 * jax.random.normal(next(keys), shape, f32)

    def small(shape, s):
        return s * jax.random.normal(next(keys), shape, f32)

    x = jax.random.normal(next(keys), (BATCH, SEQ, D_MODEL), f32)
    offset = jax.random.randint(next(keys), (BATCH, 1), 0, 1024, dtype=jnp.int32)
    positions = offset + jnp.arange(SEQ, dtype=jnp.int32)[None, :]
    return {
        'x': x,
        'positions': positions,
        'ffn1_norm': gain((L, D_MODEL)),
        'ffn1_wg': nrm((L, D_MODEL, D_FF), D_MODEL),
        'ffn1_wu': nrm((L, D_MODEL, D_FF), D_MODEL),
        'ffn1_wd': nrm((L, D_FF, D_MODEL), D_FF),
        'mix_norm': gain((L, D_MODEL)),
        'w_in': nrm((L, D_MODEL, IN_COLS), D_MODEL),
        'mla_q_norm': gain((L, A_Q_RANK)),
        'mla_kv_norm': gain((L, A_KV_RANK)),
        'mla_w_uq': nrm((L, A_Q_RANK, A_HEADS * (A_NOPE + A_ROPE)), A_Q_RANK),
        'mla_w_ukv': nrm((L, A_KV_RANK, A_HEADS * (A_NOPE + A_V)), A_KV_RANK),
        'nsa_pe_k': small((L, CMP_LEN, B_DH), 0.1),
        'nsa_pe_v': small((L, CMP_LEN, B_DH), 0.1),
        'nsa_phi_k1': nrm((L, CMP_LEN * B_DH, B_DH), CMP_LEN * B_DH),
        'nsa_phi_k2': nrm((L, B_DH, B_DH), B_DH),
        'nsa_phi_v1': nrm((L, CMP_LEN * B_DH, B_DH), CMP_LEN * B_DH),
        'nsa_phi_v2': nrm((L, B_DH, B_DH), B_DH),
        'diff_lq1': small((L, C_DH), 0.1),
        'diff_lk1': small((L, C_DH), 0.1),
        'diff_lq2': small((L, C_DH), 0.1),
        'diff_lk2': small((L, C_DH), 0.1),
        'diff_sub_norm': gain((L, 2 * C_DH)),
        'w_out': nrm((L, MIX_WIDTH, D_MODEL), MIX_WIDTH),
        'ffn2_norm': gain((L, D_MODEL)),
        'ffn2_wg': nrm((L, D_MODEL, D_FF), D_MODEL),
        'ffn2_wu': nrm((L, D_MODEL, D_FF), D_MODEL),
        'ffn2_wd': nrm((L, D_FF, D_MODEL), D_FF),
        'final_norm': gain((D_MODEL,)),
    }


def reference(x, positions, ffn1_norm, ffn1_wg, ffn1_wu, ffn1_wd, mix_norm, w_in,
              mla_q_norm, mla_kv_norm, mla_w_uq, mla_w_ukv,
              nsa_pe_k, nsa_pe_v, nsa_phi_k1, nsa_phi_k2, nsa_phi_v1, nsa_phi_v2,
              diff_lq1, diff_lk1, diff_lq2, diff_lk2, diff_sub_norm, w_out,
              ffn2_norm, ffn2_wg, ffn2_wu, ffn2_wd, final_norm):
    cs_a = rope_tables(positions, A_ROPE)
    cs_b = rope_tables(positions, B_ROT)
    cs_c = rope_tables(positions, C_ROT)
    for l in range(DEPTH):
        x = x + 0.5 * swiglu(rmsnorm(x, ffn1_norm[l]), ffn1_wg[l], ffn1_wu[l], ffn1_wd[l])
        h = rmsnorm(x, mix_norm[l]) @ w_in[l]
        h_a, h_b, h_c = jnp.split(h, [A_COLS, A_COLS + B_COLS], axis=-1)
        o_a = mla_mixer(h_a, cs_a, mla_q_norm[l], mla_kv_norm[l], mla_w_uq[l], mla_w_ukv[l])
        o_b = nsa_mixer(h_b, cs_b, nsa_pe_k[l], nsa_pe_v[l], nsa_phi_k1[l], nsa_phi_k2[l],
                        nsa_phi_v1[l], nsa_phi_v2[l])
        o_c = diff_mixer(h_c, cs_c, diff_lq1[l], diff_lk1[l], diff_lq2[l], diff_lk2[l],
                         diff_sub_norm[l], l)
        o = jnp.concatenate([o_a, o_b, o_c], axis=-1)
        x = x + o @ w_out[l]
        x = x + 0.5 * swiglu(rmsnorm(x, ffn2_norm[l]), ffn2_wg[l], ffn2_wu[l], ffn2_wd[l])
    return rmsnorm(x, final_norm)
```

```cpp
#include <hip/hip_runtime.h>
#include <hip/hip_cooperative_groups.h>
#include <cstdio>
#include <cstdint>
#include <cmath>
namespace cg = cooperative_groups;

#ifndef MK_SPLIT
#define MK_SPLIT 0
#endif

#define LAS __attribute__((address_space(3)))
typedef unsigned short bf16_t;
typedef short bf16x8 __attribute__((ext_vector_type(8)));
typedef short s16x4 __attribute__((ext_vector_type(4)));
typedef float f32x4 __attribute__((ext_vector_type(4)));
typedef float f32x16 __attribute__((ext_vector_type(16)));
typedef unsigned u32x4 __attribute__((ext_vector_type(4)));
typedef unsigned u32x2 __attribute__((ext_vector_type(2)));
typedef float f32x2_t __attribute__((ext_vector_type(2)));
typedef __bf16 bf16x2_t __attribute__((ext_vector_type(2)));

constexpr int NB = 4, T = 4096, M = NB * T, D = 1024, FF = 2816, HW = 2304, NL = 2;
constexpr float EPS = 1e-6f;
constexpr float LOG2E = 1.4426950408889634f;
constexpr float QSC_A = 0.10206207261596575f * LOG2E;
constexpr float QSC_B = 0.125f * LOG2E;
constexpr float QSC_C = 0.17677669529663687f * LOG2E;

constexpr size_t MiB = 1u << 20, KiB = 1024;
constexpr size_t WS_CTL = 0;
constexpr size_t CTL_BYTES = 64 * KiB;
constexpr size_t WS_PART = 1 * MiB;
constexpr size_t WS_RSQ = WS_PART + 1 * MiB;
constexpr size_t WS_RSKV = WS_RSQ + 64 * KiB;
constexpr size_t WS_GATES = WS_RSKV + 64 * KiB;
constexpr size_t WS_SEL = WS_GATES + 1152 * KiB;
constexpr size_t WS_TABA = WS_SEL + 256 * KiB;
constexpr size_t WS_TABB = WS_TABA + 2 * MiB;
constexpr size_t WS_TABC = WS_TABB + 1 * MiB;
constexpr size_t WS_KCMP = WS_TABC + 512 * KiB;
constexpr size_t WS_VCMP = WS_KCMP + 256 * KiB;
constexpr size_t WS_MISC = WS_VCMP + 256 * KiB;
constexpr size_t WS_W1KT = WS_MISC + 4 * KiB;
constexpr size_t WS_W1VT = WS_W1KT + 256 * KiB;
constexpr size_t WS_W2KT = WS_W1VT + 256 * KiB;
constexpr size_t WS_W2VT = WS_W2KT + 8 * KiB;
constexpr size_t WS_OCMP = 9 * MiB;
static_assert(WS_W2VT + 8 * KiB <= WS_OCMP, "small region");
constexpr size_t WS_W1A = 21 * MiB;
constexpr size_t WS_W1D = WS_W1A + 11 * MiB;
constexpr size_t WS_WIN = WS_W1D + 5632 * KiB;
constexpr size_t WS_WMLA = WS_WIN + 4608 * KiB;
constexpr size_t WS_WOUT = WS_WMLA + 1152 * KiB;
constexpr size_t WS_W2A = WS_WOUT + 2 * MiB;
constexpr size_t WS_W2D = WS_W2A + 11 * MiB;
constexpr size_t WS_XB = 62 * MiB;
static_assert(WS_W2D + 5632 * KiB <= WS_XB, "weights region");
constexpr size_t WS_A = 94 * MiB;
constexpr size_t WS_HFF = WS_A, WS_H = WS_A, WS_QKV = WS_A, WS_OBUF = WS_A + 48 * MiB;
constexpr size_t WS_P = 182 * MiB;
constexpr size_t WS_KPE = WS_P;
constexpr size_t WS_QN = WS_KPE + 1 * MiB;
constexpr size_t WS_NKV = WS_QN + 12 * MiB;
constexpr size_t WS_DQ = WS_NKV + 24 * MiB;
constexpr size_t WS_DK = WS_DQ + 8 * MiB;
constexpr size_t WS_DV = WS_DK + 8 * MiB;
constexpr size_t WS_END = WS_DV + 8 * MiB;
static_assert(WS_END <= 256 * MiB, "d_ws map");

constexpr int LDS_BYTES = 147456;

__device__ __forceinline__ unsigned cvtpk(float lo, float hi) { f32x2_t v = {lo, hi}; bf16x2_t b = __builtin_convertvector(v, bf16x2_t); return __builtin_bit_cast(unsigned, b); }
__device__ __forceinline__ float bflo(unsigned w) { return __uint_as_float(w << 16); }
__device__ __forceinline__ float bfhi(unsigned w) { return __uint_as_float(w & 0xffff0000u); }
__device__ __forceinline__ float bf1(bf16_t h) { return __uint_as_float(((unsigned)h) << 16); }
__device__ __forceinline__ bf16_t f2bf(float f) { return (bf16_t)(cvtpk(f, 0.f) & 0xffffu); }
#define WS_DPP_ADD(v, ctrl) ((v) + __builtin_bit_cast(float, __builtin_amdgcn_update_dpp(0, __builtin_bit_cast(int, (v)), (ctrl), 0xf, 0xf, true)))
__device__ __forceinline__ float wave_sum(float v) {
#pragma unroll
    for (int o = 1; o < 64; o <<= 1) v += __shfl_xor(v, o);
    return v;
}
__device__ __forceinline__ float fexp2(float x) { return __builtin_amdgcn_exp2f(x); }
__device__ __forceinline__ float frcp(float x) { return __builtin_amdgcn_rcpf(x); }
__device__ __forceinline__ float silu_f(float g) { return g * frcp(1.f + fexp2(-g * LOG2E)); }
__device__ __forceinline__ float rstd_from_part(const float* part, int row) {
    const f32x4* p = (const f32x4*)(part + (size_t)row * 16);
    const f32x4 a = p[0], b = p[1], c = p[2], d = p[3];
    const float s = ((a.x + a.y) + (a.z + a.w)) + ((b.x + b.y) + (b.z + b.w)) + ((c.x + c.y) + (c.z + c.w)) + ((d.x + d.y) + (d.z + d.w));
    return rsqrtf(s * (1.f / 1024.f) + EPS);
}

namespace pg8 {
constexpr int BM = 256, BK = 64, HALF = 128, HTB = HALF * BK * 2, STAGE_BYTES = 8 * HTB, NXCD = 8, WGM = 4;
__device__ __forceinline__ int lds_byte(int r, int c) { const int st = (r >> 4) * 2 + (c >> 5), rr = r & 15, cc = c & 31, ob = rr * 64 + cc * 2; return st * 1024 + (ob ^ (((ob >> 9) & 1) << 5)); }
__device__ __forceinline__ void stage_rc(int b, int& R, int& C) { const int st = b / 1024, sb = b % 1024, swz = sb ^ (((sb >> 9) & 1) << 5); R = (st >> 1) * 16 + swz / 64; C = (st & 1) * 32 + (swz % 64) / 2; }
__device__ __forceinline__ int perm32(int rho) { const int n = rho >> 4, i = rho & 15; return 8 * (i >> 2) + 4 * n + (i & 3); }
struct Unit { int pm, pn; };
struct Gemm { const bf16_t* A; const bf16_t* Bt; int lda, ldb, K; };
struct StaticOrder {
    int nM, nN, nwg, G, c;
    __device__ void init(int M_, int N_, int G_, int c_) { nM = M_ / BM; nN = N_ / BM; nwg = nM * nN; G = G_; c = c_; }
    __device__ bool next(int i, Unit& u) const {
        const long L = (long)i * G + c; if (L >= nwg) return false;
        int wgid = (int)L; { const int q = nwg / NXCD, r = nwg % NXCD, xcd = wgid % NXCD, off = wgid / NXCD; wgid = (xcd < r ? xcd * (q + 1) : r * (q + 1) + (xcd - r) * q) + off; }
        const int nig = WGM * nN, gid = wgid / nig, fm = gid * WGM, gsz = (nM - fm) < WGM ? (nM - fm) : WGM;
        u.pm = fm + ((wgid % nig) % gsz); u.pn = (wgid % nig) / gsz; return true;
    }
};

constexpr int RSTAB_OFF = 131072, RSTAB_UNITS = 8;
struct EpiSwiglu {
    bf16_t* H; const float* part; const LAS float* tab;
    __device__ __forceinline__ void operator()(const f32x4 (&acc)[2][2][4][2], const Unit& u, int ui, int wr, int wc, int fr, int fq) const {
        const int row0 = u.pm * BM + wr * 64 + fr; const int hc0 = u.pn * 128 + wc * 32 + 8 * fq;
        float rsv[2][4];
#pragma unroll
        for (int ai = 0; ai < 2; ++ai)
#pragma unroll
            for (int m = 0; m < 4; ++m) rsv[ai][m] = ui < RSTAB_UNITS ? tab[ui * 256 + ai * HALF + wr * 64 + m * 16 + fr] : rstd_from_part(part, row0 + ai * HALF + m * 16);
#pragma unroll
        for (int ai = 0; ai < 2; ++ai)
#pragma unroll
            for (int m = 0; m < 4; ++m) {
                const int row = row0 + ai * HALF + m * 16; const float rs = rsv[ai][m]; const float kk = -rs * LOG2E, rs2 = rs * rs;
                u32x4 w4;
#pragma unroll
                for (int bj = 0; bj < 2; ++bj) {
                    const f32x4 g = acc[ai][bj][m][0], uu = acc[ai][bj][m][1];
                    const f32x4 t = g * kk;
                    f32x4 e = {fexp2(t[0]), fexp2(t[1]), fexp2(t[2]), fexp2(t[3])};
                    e = e + 1.f;
                    const f32x4 r = {frcp(e[0]), frcp(e[1]), frcp(e[2]), frcp(e[3])};
                    const f32x4 h = ((g * uu) * rs2) * r;
                    w4[2 * bj] = cvtpk(h[0], h[1]); w4[2 * bj + 1] = cvtpk(h[2], h[3]);
                }
                *(u32x4*)(H + (size_t)row * FF + hc0) = w4;
            }
    }
};
template <int MODE> struct EpiScale {
    bf16_t* O; int ldc; const float* s0; const float* s1; const LAS float* tab;
    __device__ __forceinline__ void operator()(const f32x4 (&acc)[2][2][4][2], const Unit& u, int ui, int wr, int wc, int fr, int fq) const {
        const int row0 = u.pm * BM + wr * 64 + fr; const int col0 = u.pn * BM + wc * 32 + 8 * fq;
        const float* sp = (MODE == 0 || u.pn < 3) ? s0 : s1;
        float rsv[2][4];
#pragma unroll
        for (int ai = 0; ai < 2; ++ai)
#pragma unroll
            for (int m = 0; m < 4; ++m) { const int row = row0 + ai * HALF + m * 16;
                if (MODE == 0) rsv[ai][m] = ui < RSTAB_UNITS ? tab[ui * 256 + ai * HALF + wr * 64 + m * 16 + fr] : rstd_from_part(sp, row); else rsv[ai][m] = sp[row]; }
#pragma unroll
        for (int ai = 0; ai < 2; ++ai)
#pragma unroll
            for (int m = 0; m < 4; ++m) {
                const int row = row0 + ai * HALF + m * 16;
                const float rs = rsv[ai][m];
                bf16_t* rowp = O + (size_t)row * ldc + col0;
#pragma unroll
                for (int bj = 0; bj < 2; ++bj) {
                    const f32x4 v0 = acc[ai][bj][m][0] * rs, v1 = acc[ai][bj][m][1] * rs;
                    u32x4 w; w.x = cvtpk(v0[0], v0[1]); w.y = cvtpk(v0[2], v0[3]); w.z = cvtpk(v1[0], v1[1]); w.w = cvtpk(v1[2], v1[3]);
                    *(u32x4*)(rowp + bj * HALF) = w;
                }
            }
    }
};
__device__ __forceinline__ void route_chunk(int ch, int b, size_t& off, unsigned& ldb) {
    if (ch < 44) { off = WS_OCMP + ch * 16; ldb = 768; }
    else if (ch < 92) { const int e = ch - 44; if ((e & 7) >= 2) { off = WS_QN + e * 16; ldb = 768; } else { off = WS_H + ch * 16; ldb = HW * 2; } }
    else if (ch < 188) { const int e = ch - 92, buf = e >> 4, g = (e >> 3) & 1, hc = e & 7;
        if ((buf & 1) == 0 && hc < 2) { off = WS_H + ch * 16; ldb = HW * 2; } else { off = WS_NKV + ((size_t)buf * (8 * T * 64) + (size_t)(b + g) * T * 64 + hc * 8) * 2; ldb = 128; } }
    else if (ch < 252) { const int e = ch - 188; if ((e & 3) == 0) { off = WS_H + ch * 16; ldb = HW * 2; } else { off = (e < 32 ? WS_DQ + e * 16 : WS_DK + (e - 32) * 16); ldb = 512; } }
    else if (ch < 284) { off = WS_DV + (ch - 252) * 16; ldb = 512; }
    else { off = WS_H + ch * 16; ldb = HW * 2; }
}
struct EpiRoute {
    unsigned char* ws; const float* part; const LAS float* tab;
    __device__ __forceinline__ void operator()(const f32x4 (&acc)[2][2][4][2], const Unit& u, int ui, int wr, int wc, int fr, int fq) const {
        const int row0 = u.pm * BM + wr * 64 + fr;
        float rsv[2][4];
#pragma unroll
        for (int ai = 0; ai < 2; ++ai)
#pragma unroll
            for (int m = 0; m < 4; ++m) rsv[ai][m] = ui < RSTAB_UNITS ? tab[ui * 256 + ai * HALF + wr * 64 + m * 16 + fr] : rstd_from_part(part, row0 + ai * HALF + m * 16);
        size_t off[2]; unsigned ldb[2];
#pragma unroll
        for (int bj = 0; bj < 2; ++bj) route_chunk(u.pn * 32 + bj * 16 + wc * 4 + fq, u.pm >> 4, off[bj], ldb[bj]);
        const bool dual = (u.pn == 1 && wc == 3);
#pragma unroll
        for (int ai = 0; ai < 2; ++ai)
#pragma unroll
            for (int m = 0; m < 4; ++m) {
                const int row = row0 + ai * HALF + m * 16;
                const float rs = rsv[ai][m];
#pragma unroll
                for (int bj = 0; bj < 2; ++bj) {
                    const f32x4 v0 = acc[ai][bj][m][0] * rs, v1 = acc[ai][bj][m][1] * rs;
                    u32x4 w; w.x = cvtpk(v0[0], v0[1]); w.y = cvtpk(v0[2], v0[3]); w.z = cvtpk(v1[0], v1[1]); w.w = cvtpk(v1[2], v1[3]);
                    *(u32x4*)(ws + off[bj] + (size_t)((unsigned)row * ldb[bj])) = w;
                    if (bj == 0 && dual) *(u32x4*)(ws + WS_OCMP + (size_t)((unsigned)row * 768u) + (44 + fq) * 16) = w;
                }
            }
    }
};
struct EpiResid {
    float* X; bf16_t* XB; float* part; float alpha; int last;
    unsigned* pctr; const float* gn; LAS float* tab;
    __device__ __forceinline__ void operator()(const f32x4 (&acc)[2][2][4][2], const Unit& u, int ui, int wr, int wc, int fr, int fq) const {
        const int row0 = u.pm * BM + wr * 64 + fr; const int col0 = u.pn * BM + wc * 32 + 8 * fq;
#pragma unroll
        for (int ai = 0; ai < 2; ++ai) {
            u32x4 pre[4][2];
#pragma unroll
            for (int m = 0; m < 4; ++m) { const bf16_t* xs = XB + (size_t)(row0 + ai * HALF + m * 16) * D + col0;
#pragma unroll
                for (int bj = 0; bj < 2; ++bj) pre[m][bj] = *(const u32x4*)(xs + bj * HALF); }
#pragma unroll
            for (int m = 0; m < 4; ++m) {
                const int row = row0 + ai * HALF + m * 16; float ss = 0.f;
                float* xr = X + (size_t)row * D + col0; bf16_t* br = XB + (size_t)row * D + col0;
#pragma unroll
                for (int bj = 0; bj < 2; ++bj) {
                    const u32x4 p = pre[m][bj];
                    const f32x4 p0 = {__uint_as_float(p.x << 16), __uint_as_float(p.x & 0xffff0000u), __uint_as_float(p.y << 16), __uint_as_float(p.y & 0xffff0000u)};
                    const f32x4 p1 = {__uint_as_float(p.z << 16), __uint_as_float(p.z & 0xffff0000u), __uint_as_float(p.w << 16), __uint_as_float(p.w & 0xffff0000u)};
                    const f32x4 a0 = p0 + acc[ai][bj][m][0] * alpha, a1 = p1 + acc[ai][bj][m][1] * alpha;
                    if (last == 1) { *(f32x4*)(xr + bj * HALF) = a0; *(f32x4*)(xr + bj * HALF + 4) = a1; }
                    else if (last == 0) { u32x4 w; w.x = cvtpk(a0[0], a0[1]); w.y = cvtpk(a0[2], a0[3]); w.z = cvtpk(a1[0], a1[1]); w.w = cvtpk(a1[2], a1[3]);
                           *(u32x4*)(br + bj * HALF) = w; }
                    ss += (a0[0] * a0[0] + a0[1] * a0[1]) + (a0[2] * a0[2] + a0[3] * a0[3]) + (a1[0] * a1[0] + a1[1] * a1[1]) + (a1[2] * a1[2] + a1[3] * a1[3]);
                }
                ss += __shfl_xor(ss, 16); ss += __shfl_xor(ss, 32);
                if (fq == 0) part[(size_t)row * 16 + u.pn * 4 + wc] = ss;
            }
        }
        if (last == 2) {
            asm volatile("s_waitcnt vmcnt(0)" ::: "memory");
            __syncthreads();
            if (threadIdx.x == 0) {
                __builtin_amdgcn_fence(__ATOMIC_RELEASE, "agent"); asm volatile("s_waitcnt vmcnt(0)" ::: "memory");
                __hip_atomic_fetch_add(pctr + 64 * u.pm, 1u, __ATOMIC_RELAXED, __HIP_MEMORY_SCOPE_AGENT);
                unsigned sp = 0;
                while (__hip_atomic_load(pctr + 64 * u.pm, __ATOMIC_RELAXED, __HIP_MEMORY_SCOPE_AGENT) < 4u) { __builtin_amdgcn_s_sleep(1); if (++sp > (1u << 22)) break; }
                __builtin_amdgcn_fence(__ATOMIC_ACQUIRE, "agent"); asm volatile("s_waitcnt vmcnt(0)" ::: "memory");
            }
            __syncthreads();
            { const int t = threadIdx.x; if (t < 256) tab[t] = rstd_from_part(part, u.pm * BM + t); }
            __syncthreads();
            f32x4 gg[2][2];
#pragma unroll
            for (int bj = 0; bj < 2; ++bj) { gg[bj][0] = *(const f32x4*)(gn + col0 + bj * HALF); gg[bj][1] = *(const f32x4*)(gn + col0 + bj * HALF + 4); }
#pragma unroll
            for (int ai = 0; ai < 2; ++ai) {
                u32x4 pre[4][2];
#pragma unroll
                for (int m = 0; m < 4; ++m) { const bf16_t* xs = XB + (size_t)(row0 + ai * HALF + m * 16) * D + col0;
#pragma unroll
                    for (int bj = 0; bj < 2; ++bj) pre[m][bj] = *(const u32x4*)(xs + bj * HALF); }
#pragma unroll
                for (int m = 0; m < 4; ++m) {
                    const int row = row0 + ai * HALF + m * 16; const float rs = tab[ai * HALF + wr * 64 + m * 16 + fr];
                    float* xr = X + (size_t)row * D + col0;
#pragma unroll
                    for (int bj = 0; bj < 2; ++bj) {
                        const u32x4 p = pre[m][bj];
                        const f32x4 p0 = {__uint_as_float(p.x << 16), __uint_as_float(p.x & 0xffff0000u), __uint_as_float(p.y << 16), __uint_as_float(p.y & 0xffff0000u)};
                        const f32x4 p1 = {__uint_as_float(p.z << 16), __uint_as_float(p.z & 0xffff0000u), __uint_as_float(p.w << 16), __uint_as_float(p.w & 0xffff0000u)};
                        const f32x4 a0 = p0 + acc[ai][bj][m][0] * alpha, a1 = p1 + acc[ai][bj][m][1] * alpha;
                        *(f32x4*)(xr + bj * HALF) = a0 * rs * gg[bj][0]; *(f32x4*)(xr + bj * HALF + 4) = a1 * rs * gg[bj][1];
                    }
                }
            }
        }
    }
};

template <class Epi>
__device__ __forceinline__ void gemm_phase(LAS unsigned char* lds, const int tid, const Gemm g, const StaticOrder& S, const Epi& E) {
    const int wid = __builtin_amdgcn_readfirstlane(tid >> 6), lane = tid & 63, wr = wid >> 2, wc = wid & 3, fr = lane & 15, fq = lane >> 4;
    const int K = g.K, nt = K / BK;
    unsigned voffA[2], voffB[2];
#pragma unroll
    for (int i = 0; i < 2; ++i) { int R, C; stage_rc(tid * 16 + i * 8192, R, C); const int Rb = (R & ~31) + perm32(R & 31);
        voffA[i] = (unsigned)(R * g.lda + C) * 2u; voffB[i] = (unsigned)(Rb * g.ldb + C) * 2u; }
    const size_t kstep = (size_t)(BK * 2);
    const size_t hstepA = (size_t)HALF * g.lda * 2, hstepB = (size_t)HALF * g.ldb * 2;
    const size_t tstepA = 2 * hstepA, tstepB = 2 * hstepB;
    const unsigned ldsw = (unsigned)wid * 1024u;
    const int aoff = lds_byte(wr * 64 + fr, fq * 8), boff = lds_byte(wc * 32 + fr, fq * 8);
#define PG8_SA(b, h) (((b) * 2 + (h)) * HTB)
#define PG8_SB(b, h) ((4 + (b) * 2 + (h)) * HTB)
#define PG8_STAGE(bufoff, gbase, voff) do { _Pragma("unroll") for (int _i = 0; _i < 2; ++_i) \
        __builtin_amdgcn_global_load_lds((const unsigned*)((const char*)(gbase) + (voff)[_i]), (LAS unsigned*)(lds + (bufoff) + ldsw + _i * 8192), 16, 0, 0); } while (0)
#define PG8_LDA(dst, b, h) do { _Pragma("unroll") for (int m = 0; m < 4; ++m) _Pragma("unroll") for (int k = 0; k < 2; ++k) dst[m][k] = *(const LAS bf16x8*)(lds + PG8_SA(b, h) + aoff + m * 2048 + k * 1024); } while (0)
#define PG8_LDB(dst, b, h) do { _Pragma("unroll") for (int n = 0; n < 2; ++n) _Pragma("unroll") for (int k = 0; k < 2; ++k) dst[n][k] = *(const LAS bf16x8*)(lds + PG8_SB(b, h) + boff + n * 2048 + k * 1024); } while (0)
#define PG8_MMA(ai, bj, At, Bt) do { __builtin_amdgcn_s_setprio(1); _Pragma("unroll") for (int m = 0; m < 4; ++m) _Pragma("unroll") for (int n = 0; n < 2; ++n) _Pragma("unroll") for (int k = 0; k < 2; ++k) \
        acc[ai][bj][m][n] = __builtin_amdgcn_mfma_f32_16x16x32_bf16(Bt[n][k], At[m][k], acc[ai][bj][m][n], 0, 0, 0); __builtin_amdgcn_s_setprio(0); } while (0)
#define PG8_WAIT_V(n) asm volatile("s_waitcnt vmcnt(" #n ")" ::: "memory")
#define PG8_WAIT_L(n) asm volatile("s_waitcnt lgkmcnt(" #n ")" ::: "memory")
#define PG8_BAR __builtin_amdgcn_s_barrier()
#define PG8_SCHED __builtin_amdgcn_sched_barrier(0)
    Unit cur, nxt; int ui = 0;
    if (!S.next(0, cur)) return;
    f32x4 acc[2][2][4][2];
#pragma unroll
    for (int a = 0; a < 2; ++a)
#pragma unroll
        for (int b = 0; b < 2; ++b)
#pragma unroll
            for (int m = 0; m < 4; ++m)
#pragma unroll
                for (int n = 0; n < 2; ++n) acc[a][b][m][n] = (f32x4){0.f, 0.f, 0.f, 0.f};
    bf16x8 At[4][2], B0[2][2], B1[2][2];
    const char* cA = (const char*)g.A + (size_t)cur.pm * tstepA; const char* cB = (const char*)g.Bt + (size_t)cur.pn * tstepB;
    PG8_STAGE(PG8_SB(0, 0), cB, voffB); PG8_STAGE(PG8_SB(0, 1), cB + hstepB, voffB); PG8_STAGE(PG8_SA(0, 0), cA, voffA); PG8_STAGE(PG8_SA(0, 1), cA + hstepA, voffA);
    if (wr == 1) PG8_BAR;
    PG8_WAIT_V(2); PG8_BAR;
    PG8_STAGE(PG8_SB(1, 0), cB + kstep, voffB); PG8_STAGE(PG8_SA(1, 0), cA + kstep, voffA); PG8_STAGE(PG8_SB(1, 1), cB + hstepB + kstep, voffB);
    PG8_WAIT_V(6); PG8_BAR;
    for (;;) {
        const bool has_next = S.next(ui + 1, nxt);
        const char* nA = has_next ? (const char*)g.A + (size_t)nxt.pm * tstepA : cA; const char* nB = has_next ? (const char*)g.Bt + (size_t)nxt.pn * tstepB : cB;
#pragma unroll 1
        for (int t = 0; t < nt; t += 2) {
            const bool last = (t == nt - 2);
            const char* a1 = cA + (size_t)(t + 1) * kstep;
            const char* a2 = last ? nA : cA + (size_t)(t + 2) * kstep; const char* b2 = last ? nB : cB + (size_t)(t + 2) * kstep;
            const char* a3 = a2 + kstep; const char* b3 = b2 + kstep;
            PG8_LDB(B0, 0, 0); PG8_LDB(B1, 0, 1); PG8_SCHED; PG8_LDA(At, 0, 0); PG8_STAGE(PG8_SA(1, 1), a1 + hstepA, voffA);
            PG8_WAIT_V(8); PG8_WAIT_L(0); PG8_BAR; PG8_MMA(0, 0, At, B0); PG8_MMA(0, 1, At, B1); PG8_BAR; PG8_SCHED;
            PG8_LDA(At, 0, 1); PG8_STAGE(PG8_SB(0, 0), b2, voffB); PG8_STAGE(PG8_SB(0, 1), b2 + hstepB, voffB); PG8_STAGE(PG8_SA(0, 0), a2, voffA);
            PG8_WAIT_V(8); PG8_WAIT_L(0); PG8_BAR; PG8_MMA(1, 0, At, B0); PG8_MMA(1, 1, At, B1); PG8_BAR; PG8_SCHED;
            PG8_LDB(B0, 1, 0); PG8_LDB(B1, 1, 1); PG8_SCHED; PG8_LDA(At, 1, 0); PG8_STAGE(PG8_SA(0, 1), a2 + hstepA, voffA);
            PG8_WAIT_V(8); PG8_WAIT_L(0); PG8_BAR; PG8_MMA(0, 0, At, B0); PG8_MMA(0, 1, At, B1); PG8_BAR; PG8_SCHED;
            PG8_LDA(At, 1, 1); PG8_STAGE(PG8_SB(1, 0), b3, voffB); PG8_STAGE(PG8_SB(1, 1), b3 + hstepB, voffB); PG8_STAGE(PG8_SA(1, 0), a3, voffA);
            PG8_WAIT_V(8); PG8_WAIT_L(0); PG8_BAR; PG8_MMA(1, 0, At, B0); PG8_MMA(1, 1, At, B1); PG8_BAR; PG8_SCHED;
        }
        if (wr == 0) PG8_BAR;
        E(acc, cur, ui, wr, wc, fr, fq);
        if (!has_next) break;
#pragma unroll
        for (int a = 0; a < 2; ++a)
#pragma unroll
            for (int b = 0; b < 2; ++b)
#pragma unroll
                for (int m = 0; m < 4; ++m)
#pragma unroll
                    for (int n = 0; n < 2; ++n) acc[a][b][m][n] = (f32x4){0.f, 0.f, 0.f, 0.f};
        cur = nxt; cA = nA; cB = nB; ++ui;
        if (wr == 1) PG8_BAR;
    }
    PG8_WAIT_V(0);
    PG8_BAR;
#undef PG8_SA
#undef PG8_SB
#undef PG8_STAGE
#undef PG8_LDA
#undef PG8_LDB
#undef PG8_MMA
#undef PG8_WAIT_V
#undef PG8_WAIT_L
#undef PG8_BAR
#undef PG8_SCHED
}
}

namespace att {
constexpr int KOFF = 0, VOFF = 12288, WSOFF = 20480;
__device__ __forceinline__ int crow(int r, int hi) { return (r & 3) + 8 * (r >> 2) + 4 * hi; }
__device__ __forceinline__ s16x4 vtr(const LAS unsigned char* p) { return __builtin_bit_cast(s16x4, __builtin_amdgcn_ds_read_tr16_b64_v4i16((LAS s16x4*)p)); }

struct Stage { u32x4 k0, k1, v; };
struct KV { const bf16_t* K; int kp; const bf16_t* K2; int kp2; const bf16_t* V; int vp; };

template <int DK> __device__ __forceinline__ void stage_load(Stage& s, const KV& kv, int kv0, int wid, int lane) {
    if (DK >= 64 || wid < DK / 8) s.k0 = *(const u32x4*)(kv.K + (size_t)(kv0 + lane) * kv.kp + wid * 8);
    if (DK == 96 && wid < 4) s.k1 = *(const u32x4*)(kv.K2 + (size_t)(kv0 + lane) * kv.kp2 + wid * 8);
    s.v = *(const u32x4*)(kv.V + (size_t)(kv0 + 16 * (wid & 3) + (lane >> 2)) * kv.vp + (wid >> 2) * 32 + (lane & 3) * 8);
}
template <int DK> __device__ __forceinline__ void stage_store(const Stage& s, LAS unsigned char* lds, int wid, int lane) {
    if (DK >= 64 || wid < DK / 8) *(LAS u32x4*)(lds + KOFF + wid * 1024 + lane * 16) = s.k0;
    if (DK == 96 && wid < 4) *(LAS u32x4*)(lds + KOFF + (8 + wid) * 1024 + lane * 16) = s.k1;
    *(LAS u32x4*)(lds + VOFF + wid * 1024 + lane * 16) = s.v;
}
template <int DK> __device__ __forceinline__ void qk_tile(f32x16& p0, f32x16& p1, const LAS unsigned char* kl, const bf16x8 (&qr)[DK / 16], int r32, int hi) {
    p0 = (f32x16){0.f, 0.f, 0.f, 0.f, 0.f, 0.f, 0.f, 0.f, 0.f, 0.f, 0.f, 0.f, 0.f, 0.f, 0.f, 0.f}; p1 = p0;
#pragma unroll
    for (int d0 = 0; d0 < DK / 16; ++d0) {
        const bf16x8 b0 = *(const LAS bf16x8*)(kl + (2 * d0 + hi) * 1024 + r32 * 16);
        const bf16x8 b1 = *(const LAS bf16x8*)(kl + (2 * d0 + hi) * 1024 + 512 + r32 * 16);
        p0 = __builtin_amdgcn_mfma_f32_32x32x16_bf16(b0, qr[d0], p0, 0, 0, 0);
        p1 = __builtin_amdgcn_mfma_f32_32x32x16_bf16(b1, qr[d0], p1, 0, 0, 0);
    }
}
__device__ __forceinline__ float max32(const f32x16& p0, const f32x16& p1) {
    float a = fmaxf(p0[0], p1[0]);
#pragma unroll
    for (int r = 1; r < 16; ++r) a = fmaxf(a, fmaxf(p0[r], p1[r]));
    return fmaxf(a, __shfl_xor(a, 32));
}
__device__ __forceinline__ bf16x8 pack8(const f32x16& p, int b) {
    u32x4 w; w.x = cvtpk(p[b], p[b + 1]); w.y = cvtpk(p[b + 2], p[b + 3]); w.z = cvtpk(p[b + 4], p[b + 5]); w.w = cvtpk(p[b + 6], p[b + 7]);
    return __builtin_bit_cast(bf16x8, w);
}
__device__ __forceinline__ void pv_tile(f32x16 (&o)[2], const f32x16& p0, const f32x16& p1, const LAS unsigned char* vl, int lane, int hi) {
    const bf16x8 pa0 = pack8(p0, 0), pa1 = pack8(p0, 8), pa2 = pack8(p1, 0), pa3 = pack8(p1, 8);
    const LAS unsigned char* vb = vl + ((lane >> 4) & 1) * 32 + (lane & 3) * 8 + (4 * hi + ((lane & 15) >> 2)) * 64;
#pragma unroll
    for (int d0 = 0; d0 < 2; ++d0) {
#pragma unroll
        for (int ks = 0; ks < 4; ++ks) {
            const s16x4 lo = vtr(vb + d0 * 4096 + ks * 1024), hh = vtr(vb + d0 * 4096 + ks * 1024 + 512);
            const bf16x8 vf = (bf16x8){lo[0], lo[1], lo[2], lo[3], hh[0], hh[1], hh[2], hh[3]};
            const bf16x8 pa = ks == 0 ? pa0 : ks == 1 ? pa1 : ks == 2 ? pa2 : pa3;
            o[d0] = __builtin_amdgcn_mfma_f32_32x32x16_bf16(pa, vf, o[d0], 0, 0, 0);
        }
    }
}
template <int MODE> __device__ __forceinline__ void mask_tile(f32x16& p0, f32x16& p1, int kvb, int qpos, bool rowoff) {
    const float NEG = -INFINITY;
#pragma unroll
    for (int r = 0; r < 16; ++r) {
        const int kv = kvb + (r & 3) + 8 * (r >> 2);
        bool k0 = kv > qpos, k1 = kv + 32 > qpos;
        if (MODE == 2) { k0 = k0 || (qpos - kv >= 512); k1 = k1 || (qpos - kv - 32 >= 512); }
        if (MODE == 1) { k0 = k0 || rowoff; k1 = k1 || rowoff; }
        if (k0) p0[r] = NEG; if (k1) p1[r] = NEG;
    }
}
template <int DK, int MODE>
__device__ __forceinline__ void attn_tiles(f32x16 (&o)[2], float& m_run, float& l_run, const bf16x8 (&qr)[DK / 16], const KV& kv, int t_lo, int t_hi, int q0w, unsigned long long sel,
                                           LAS unsigned char* lds, int wid, int lane) {
    const int r32 = lane & 31, hi = lane >> 5, qpos = q0w + r32;
    LAS float* wsf = (LAS float*)(lds + WSOFF + wid * 256);
    Stage st; stage_load<DK>(st, kv, t_lo * 64, wid, lane);
    for (int t = t_lo; t < t_hi; ++t) {
        stage_store<DK>(st, lds, wid, lane);
        __syncthreads();
        if (t + 1 < t_hi) stage_load<DK>(st, kv, (t + 1) * 64, wid, lane);
        bool need = (t * 64 <= q0w + 31);
        if (MODE == 2) need = need && (t * 64 + 63 >= q0w - 511);
        if (need) {
            f32x16 p0, p1;
            qk_tile<DK>(p0, p1, lds + KOFF, qr, r32, hi);
            const bool full = (t * 64 + 63 <= q0w) && (MODE != 2 || (q0w + 31 - t * 64 < 512)) && (MODE != 1);
            if (!full) mask_tile<MODE>(p0, p1, t * 64 + 4 * hi, qpos, MODE == 1 ? !((sel >> t) & 1ull) : false);
            const float mx = max32(p0, p1);
            const float mn = fmaxf(m_run, mx);
            if (__any(mn > m_run)) {
                const float f = fexp2(m_run - mn);
                l_run *= f; m_run = mn;
                wsf[r32] = f;
#pragma unroll
                for (int r = 0; r < 16; ++r) { const float fr_ = wsf[crow(r, hi)]; o[0][r] *= fr_; o[1][r] *= fr_; }
            }
            float s = 0.f;
#pragma unroll
            for (int r = 0; r < 16; ++r) { p0[r] = fexp2(p0[r] - m_run); p1[r] = fexp2(p1[r] - m_run); s += p0[r] + p1[r]; }
            l_run += s;
            pv_tile(o, p0, p1, lds + VOFF, lane, hi);
        }
        __syncthreads();
    }
}
__device__ __forceinline__ void attn_finish(f32x16 (&o)[2], float l_run, LAS unsigned char* lds, int wid, int lane) {
    const int r32 = lane & 31, hi = lane >> 5;
    LAS float* wsf = (LAS float*)(lds + WSOFF + wid * 256);
    const float lt = l_run + __shfl_xor(l_run, 32);
    wsf[r32] = lt > 0.f ? 1.f / lt : 0.f;
#pragma unroll
    for (int r = 0; r < 16; ++r) { const float f = wsf[crow(r, hi)]; o[0][r] *= f; o[1][r] *= f; }
}
__device__ __forceinline__ void zero_o(f32x16 (&o)[2]) {
    o[0] = (f32x16){0.f, 0.f, 0.f, 0.f, 0.f, 0.f, 0.f, 0.f, 0.f, 0.f, 0.f, 0.f, 0.f, 0.f, 0.f, 0.f}; o[1] = o[0];
}
}

namespace fa {
typedef const LAS char* lds_cptr;
constexpr int SLOTB = 8192, LDS_K = 0, LDS_V = 3 * SLOTB, LDS_WS = 6 * SLOTB;
__device__ __forceinline__ int crow(int r, int hi) { return (r & 3) + 8 * (r >> 2) + 4 * hi; }
__device__ __forceinline__ void glds16(const void* gsrc, unsigned lds_dst) { unsigned keep;
    asm volatile("s_mov_b32 %0, m0\n\ts_mov_b32 m0, %2\n\ts_nop 0\n\tglobal_load_lds_dwordx4 %1, off\n\ts_mov_b32 m0, %0" : "=&s"(keep) : "v"(gsrc), "s"(lds_dst) : "memory"); }
__device__ __forceinline__ float max3f(float a, float b, float c) { float r; asm("v_max3_f32 %0, %1, %2, %3" : "=v"(r) : "v"(a), "v"(b), "v"(c)); return r; }
__device__ __forceinline__ float max2f(float a, float b) { float r; asm("v_max_f32_e32 %0, %1, %2" : "=v"(r) : "v"(a), "v"(b)); return r; }
__device__ __forceinline__ float fadd_s(float a, float b) { float r; asm("v_add_f32_e32 %0, %1, %2" : "=v"(r) : "v"(a), "v"(b)); return r; }
__device__ __forceinline__ float fsub_s(float a, float b) { float r; asm("v_sub_f32_e32 %0, %1, %2" : "=v"(r) : "v"(a), "v"(b)); return r; }
#define FA_SBAR() __builtin_amdgcn_sched_barrier(0)
#define FA_WAIT_BAR(N) asm volatile("s_waitcnt vmcnt(" #N ") lgkmcnt(0)\n\ts_barrier" ::: "memory")
template <int NKS> __device__ __forceinline__ void qkt(f32x16& p0, f32x16& p1, lds_cptr Kslot, const bf16x8* qr, const f32x16& negm, int r32, int hi) {
    lds_cptr kb = Kslot + hi * 1024 + r32 * 16;
#pragma unroll
    for (int d0 = 0; d0 < NKS; ++d0) {
        const bf16x8 b0 = *(const LAS bf16x8*)(kb + d0 * 2048), b1 = *(const LAS bf16x8*)(kb + d0 * 2048 + 512);
        if (d0 == 0) { p0 = __builtin_amdgcn_mfma_f32_32x32x16_bf16(b0, qr[0], negm, 0, 0, 0); p1 = __builtin_amdgcn_mfma_f32_32x32x16_bf16(b1, qr[0], negm, 0, 0, 0); }
        else { p0 = __builtin_amdgcn_mfma_f32_32x32x16_bf16(b0, qr[d0], p0, 0, 0, 0); p1 = __builtin_amdgcn_mfma_f32_32x32x16_bf16(b1, qr[d0], p1, 0, 0, 0); }
    }
}
template <int NKS> __device__ __forceinline__ void kloadall(bf16x8* kf, lds_cptr kp) {
#pragma unroll
    for (int j = 0; j < NKS; ++j) { kf[2 * j] = *(const LAS bf16x8*)(kp + j * 2048); kf[2 * j + 1] = *(const LAS bf16x8*)(kp + j * 2048 + 512); }
}
__device__ __forceinline__ void kload2(bf16x8* kf, lds_cptr kp, int j) { kf[2 * j] = *(const LAS bf16x8*)(kp + j * 2048); kf[2 * j + 1] = *(const LAS bf16x8*)(kp + j * 2048 + 512); }
__device__ __forceinline__ s16x4 vtr(lds_cptr p) { return __builtin_bit_cast(s16x4, __builtin_amdgcn_ds_read_tr16_b64_v4i16((LAS s16x4*)p)); }
__device__ __forceinline__ float rowmax(const f32x16& p0, const f32x16& p1) {
    float a = max3f(p0[0], p0[1], p1[0]), b = max3f(p0[2], p0[3], p1[1]); a = max3f(a, p1[2], p1[3]);
#pragma unroll
    for (int r = 4; r < 16; r += 4) { a = max3f(a, p0[r], p0[r + 1]); b = max3f(b, p0[r + 2], p0[r + 3]); a = max3f(a, p1[r], p1[r + 1]); b = max3f(b, p1[r + 2], p1[r + 3]); }
    const float m = max2f(a, b);
    auto rr = __builtin_amdgcn_permlane32_swap(__float_as_uint(m), __float_as_uint(m), false, false);
    return max2f(__uint_as_float(rr[0]), __uint_as_float(rr[1]));
}
__device__ __forceinline__ void pv(f32x16* o, lds_cptr vb, bf16x8 pa0, bf16x8 pa1, bf16x8 pa2, bf16x8 pa3) {
#pragma unroll
    for (int d0 = 0; d0 < 2; ++d0) {
        s16x4 lo[4], hh[4];
#pragma unroll
        for (int ks = 0; ks < 4; ++ks) { lo[ks] = vtr(vb + d0 * 4096 + ks * 1024); hh[ks] = vtr(vb + d0 * 4096 + ks * 1024 + 512); }
#define FA_PK(k) (bf16x8){lo[k][0], lo[k][1], lo[k][2], lo[k][3], hh[k][0], hh[k][1], hh[k][2], hh[k][3]}
        o[d0] = __builtin_amdgcn_mfma_f32_32x32x16_bf16(pa0, FA_PK(0), o[d0], 0, 0, 0);
        o[d0] = __builtin_amdgcn_mfma_f32_32x32x16_bf16(pa1, FA_PK(1), o[d0], 0, 0, 0);
        o[d0] = __builtin_amdgcn_mfma_f32_32x32x16_bf16(pa2, FA_PK(2), o[d0], 0, 0, 0);
        o[d0] = __builtin_amdgcn_mfma_f32_32x32x16_bf16(pa3, FA_PK(3), o[d0], 0, 0, 0);
#undef FA_PK
    }
}
template <int MODE> __device__ __forceinline__ void mask(f32x16& p0, f32x16& p1, int lim, bool rowoff) {
    if (MODE == 1) lim = rowoff ? -1 : lim;
    asm volatile("" : "+v"(lim));
#pragma unroll
    for (int r = 0; r < 16; ++r) {
        const int cr = (r & 3) + 8 * (r >> 2);
        bool k0 = lim < cr, k1 = lim < cr + 32;
        if (MODE == 2) { k0 = k0 || (lim >= 512 + cr); k1 = k1 || (lim >= 544 + cr); }
        if (k0) p0[r] = -INFINITY; if (k1) p1[r] = -INFINITY;
    }
}
struct Src { const bf16_t* K; int kp; const bf16_t* V; int vp; };
template <int NKS, int MODE, int THRL>
__device__ __forceinline__ void unit(f32x16 (&o)[2], const bf16x8 (&qr)[NKS], const Src& src, int t_lo, int t_hi, int q0w, unsigned long long sel, LAS unsigned char* shm, int wid, int lane) {
    const int r32 = lane & 31, hi = lane >> 5, qpos = q0w + r32;
    const unsigned lds0 = (unsigned)(uintptr_t)shm;
    LAS float* wsf = (LAS float*)(shm + LDS_WS) + wid * 64;
    const int pk = NKS == 2 ? (wid & 3) : wid;
    const bf16_t* ksrc = src.K + (size_t)(t_lo * 64 + lane) * src.kp + pk * 8;
    const bf16_t* vsrc = src.V + (size_t)(t_lo * 64 + 16 * (wid & 3) + (lane >> 2)) * src.vp + (wid >> 2) * 32 + (lane & 3) * 8;
    const unsigned kdst = lds0 + LDS_K + pk * 1024, vdst = lds0 + LDS_V + wid * 1024;
    const size_t ktile = (size_t)64 * src.kp, vtile = (size_t)64 * src.vp;
#define DMA_K(t, slot) glds16(ksrc + (size_t)(t) * ktile, (unsigned)__builtin_amdgcn_readfirstlane(kdst + (slot)))
#define DMA_V(t, slot) glds16(vsrc + (size_t)(t) * vtile, (unsigned)__builtin_amdgcn_readfirstlane(vdst + (slot)))
    const lds_cptr shm3 = (lds_cptr)shm; const lds_cptr kp0 = shm3 + LDS_K + hi * 1024 + r32 * 16;
    const lds_cptr vp0 = shm3 + LDS_V + ((lane >> 4) & 1) * 32 + (lane & 3) * 8 + (4 * hi + ((lane & 15) >> 2)) * 64;
    bf16x8 kf[8];
    const int NT = t_hi - t_lo;
    DMA_K(0, 0); DMA_V(0, 0); DMA_K(1, SLOTB);
    float mhat = 0.f, l_reg = 0.f; o[0] = f32x16{}; o[1] = f32x16{}; f32x16 negm = f32x16{}; asm volatile("" : "+v"(negm));
#define CMASK(P0, P1, t) do { \
    if (MODE == 0) { if ((t) >= NT - 4) mask<0>(P0, P1, qpos - 4 * hi - (t_lo + (t)) * 64, false); } \
    else if (MODE == 1) { const bool off_ = !((sel >> (t_lo + (t))) & 1ull); \
        if ((t) >= NT - 4) mask<1>(P0, P1, qpos - 4 * hi - (t_lo + (t)) * 64, off_); \
        else { _Pragma("unroll") for (int r_ = 0; r_ < 16; ++r_) { P0[r_] = off_ ? -INFINITY : P0[r_]; P1[r_] = off_ ? -INFINITY : P1[r_]; } } } \
    else { const int ts_ = (t_lo + (t)) * 64; if (!((ts_ + 63 <= q0w) && (q0w + 31 - ts_ < 512))) mask<2>(P0, P1, qpos - 4 * hi - ts_, false); } } while (0)
    bool resc = false;
#define START(P0, P1) do { const float rm = rowmax(P0, P1); resc = false; \
    { const float dl = rm > -1e30f ? rm : 0.f; mhat = fadd_s(mhat, dl); \
      _Pragma("unroll") for (int r = 0; r < 16; ++r) { P0[r] = fsub_s(P0[r], dl); P1[r] = fsub_s(P1[r], dl); } \
      _Pragma("unroll") for (int r = 0; r < 16; ++r) negm[r] = -mhat; asm volatile("" : "+v"(negm)); } \
    _Pragma("unroll") for (int r = 0; r < 16; ++r) P0[r] = __builtin_amdgcn_exp2f(P0[r]); } while (0)
#define RESC() do { if (resc) { asm volatile("s_waitcnt lgkmcnt(0)" ::: "memory"); \
      _Pragma("unroll") for (int d_ = 0; d_ < 2; ++d_) _Pragma("unroll") for (int r = 0; r < 16; ++r) o[d_][r] *= wsf[crow(r, hi)]; } } while (0)
    f32x16 pA0, pA1, pB0, pB1;
    int sl_prev = 0, sl_cur = 0, sl_next = SLOTB;
#define ROT() do { sl_prev = sl_cur; sl_cur = sl_next; sl_next = (sl_next == 2 * SLOTB) ? 0 : sl_next + SLOTB; } while (0)
    DMA_K(2, 2 * SLOTB);
    FA_WAIT_BAR(3);
    qkt<NKS>(pA0, pA1, shm3 + LDS_K, qr, negm, r32, hi); asm volatile("s_nop 15\n\ts_nop 7" : "+v"(pA0), "+v"(pA1)); CMASK(pA0, pA1, 0);
    START(pA0, pA1);
    _Pragma("unroll") for (int r = 0; r < 16; ++r) pA1[r] = __builtin_amdgcn_exp2f(pA1[r]);
    FA_WAIT_BAR(0);
    DMA_K(3, 0); DMA_V(1, SLOTB);
    ROT();
    kloadall<NKS>(kf, kp0 + sl_cur);
    FA_WAIT_BAR(2);
    s16x4 vlo[8], vhi[8]; u32x4 pw0, pw1, pw2, pw3;
#define PKW(P, B) cvtpk(P[B], P[B + 1])
#define PAF(k) __builtin_bit_cast(bf16x8, pw##k)
#define VFR(i) (bf16x8){vlo[i][0], vlo[i][1], vlo[i][2], vlo[i][3], vhi[i][0], vhi[i][1], vhi[i][2], vhi[i][3]}
#define PIN(x) asm volatile("" : "+v"(x))
#define MX3(a, b, c) __builtin_fmaxf(__builtin_fmaxf((a), (b)), (c))
#define GAPA(MF, A0, A1, A2, A3, W0, W1, PW) do { MF; sacc += A0; sacc += A1; sacc += A2; sacc += A3; PIN(sacc); W0; W1; PIN(PW); FA_SBAR(); } while (0)
#define EX(v) __builtin_amdgcn_exp2f(v)
#define GAPB(MF, X, B) do { MF; X[B] = EX(X[B]); X[B + 1] = EX(X[B + 1]); X[B + 2] = EX(X[B + 2]); X[B + 3] = EX(X[B + 3]); PIN(X); FA_SBAR(); } while (0)
#define VRD(i) do { vlo[i] = vtr(vp_ + (((i) >> 2) * 4096 + ((i) & 3) * 1024)); vhi[i] = vtr(vp_ + (((i) >> 2) * 4096 + ((i) & 3) * 1024 + 512)); } while (0)
#define KRD(G, j) do { if ((G) && (j) < NKS) { kload2(kf, kp0 + sl_next, j); FA_SBAR(); } } while (0)
#define QK0(C, kidx, qidx) C = __builtin_amdgcn_mfma_f32_32x32x16_bf16(kf[kidx], qr[qidx], negm, 0, 0, 0)
#define QKN(C, kidx, qidx) do { if (NKS > (qidx)) C = __builtin_amdgcn_mfma_f32_32x32x16_bf16(kf[kidx], qr[(qidx) < NKS ? (qidx) : 0], C, 0, 0, 0); } while (0)
#define STEP(C0, C1, P0, P1, t, GK, GV, GL) do { FA_SBAR(); \
    const lds_cptr vp_ = vp0 + sl_prev; \
    VRD(0); FA_SBAR(); float sacc = (P0[0] + P0[1]); \
    GAPA(QK0(C0, 0, 0),     P0[2], P0[3], P0[4], P0[5],     pw0[0] = PKW(P0, 0), pw0[1] = PKW(P0, 2), pw0); \
    VRD(4); FA_SBAR(); GAPA(QK0(C1, 1, 0),     P0[6], P0[7], P0[8], P0[9],     pw0[2] = PKW(P0, 4), pw0[3] = PKW(P0, 6), pw0); \
    VRD(1); FA_SBAR(); GAPA(QKN(C0, 2, 1),     P0[10], P0[11], P0[12], P0[13], pw1[0] = PKW(P0, 8), pw1[1] = PKW(P0, 10), pw1); \
    VRD(5); FA_SBAR(); GAPA(QKN(C1, 3, 1),     P0[14], P0[15], P1[0], P1[1],   pw1[2] = PKW(P0, 12), pw1[3] = PKW(P0, 14), pw1); \
    VRD(2); FA_SBAR(); GAPA(QKN(C0, 4, 2),     P1[2], P1[3], P1[4], P1[5],     pw2[0] = PKW(P1, 0), pw2[1] = PKW(P1, 2), pw2); \
    VRD(6); FA_SBAR(); GAPA(QKN(C1, 5, 2),     P1[6], P1[7], P1[8], P1[9],     pw2[2] = PKW(P1, 4), pw2[3] = PKW(P1, 6), pw2); \
    VRD(3); FA_SBAR(); GAPA(QKN(C0, 6, 3),     P1[10], P1[11], P1[12], P1[13], pw3[0] = PKW(P1, 8), pw3[1] = PKW(P1, 10), pw3); \
    VRD(7); FA_SBAR(); GAPA(QKN(C1, 7, 3),     P1[14], P1[15], 0.f, 0.f,       pw3[2] = PKW(P1, 12), pw3[3] = PKW(P1, 14), pw3); \
    l_reg += sacc; \
    if (GK) { DMA_K((t) + 3, sl_cur); } if (GV) { DMA_V((t) + 1, sl_next); } \
    CMASK(C0, C1, t); \
    { float a = MX3(C0[0], C0[1], C1[0]), b = MX3(C0[2], C0[3], C1[1]); a = MX3(a, C1[2], C1[3]); \
      _Pragma("unroll") for (int r = 4; r < 16; r += 4) { a = MX3(a, C0[r], C0[r + 1]); b = MX3(b, C0[r + 2], C0[r + 3]); a = MX3(a, C1[r], C1[r + 1]); b = MX3(b, C1[r + 2], C1[r + 3]); } \
      float rm = __builtin_fmaxf(a, b); { auto rr = __builtin_amdgcn_permlane32_swap(__float_as_uint(rm), __float_as_uint(rm), false, false); rm = __builtin_fmaxf(__uint_as_float(rr[0]), __uint_as_float(rr[1])); } \
      resc = false; \
      if (__builtin_expect(__any(rm > (float)THRL), 0)) { const float dl = __builtin_fmaxf(rm, 0.f); mhat += dl; \
        _Pragma("unroll") for (int r = 0; r < 16; ++r) { C0[r] -= dl; C1[r] -= dl; } \
        _Pragma("unroll") for (int r = 0; r < 16; ++r) negm[r] = -mhat; asm volatile("" : "+v"(negm)); \
        const float f = __builtin_amdgcn_exp2f(-dl); l_reg *= f; { int l2_ = lane; asm volatile("" : "+v"(l2_)); if (l2_ < 32) wsf[l2_] = f; } resc = true; } } \
    FA_SBAR(); \
    GAPB(o[0] = __builtin_amdgcn_mfma_f32_32x32x16_bf16(PAF(0), VFR(0), o[0], 0, 0, 0), C0, 0); \
    GAPB(o[1] = __builtin_amdgcn_mfma_f32_32x32x16_bf16(PAF(0), VFR(4), o[1], 0, 0, 0), C0, 4); \
    KRD(GL, 0); GAPB(o[0] = __builtin_amdgcn_mfma_f32_32x32x16_bf16(PAF(1), VFR(1), o[0], 0, 0, 0), C0, 8); \
    KRD(GL, 1); GAPB(o[1] = __builtin_amdgcn_mfma_f32_32x32x16_bf16(PAF(1), VFR(5), o[1], 0, 0, 0), C0, 12); \
    KRD(GL, 2); GAPB(o[0] = __builtin_amdgcn_mfma_f32_32x32x16_bf16(PAF(2), VFR(2), o[0], 0, 0, 0), C1, 0); \
    KRD(GL, 3); GAPB(o[1] = __builtin_amdgcn_mfma_f32_32x32x16_bf16(PAF(2), VFR(6), o[1], 0, 0, 0), C1, 4); \
    GAPB(o[0] = __builtin_amdgcn_mfma_f32_32x32x16_bf16(PAF(3), VFR(3), o[0], 0, 0, 0), C1, 8); \
    GAPB(o[1] = __builtin_amdgcn_mfma_f32_32x32x16_bf16(PAF(3), VFR(7), o[1], 0, 0, 0), C1, 12); \
    } while (0)
    int t = 1;
    for (; t + 5 < NT; t += 2) {
        STEP(pB0, pB1, pA0, pA1, t, true, true, true);       FA_WAIT_BAR(2); RESC(); ROT();
        STEP(pA0, pA1, pB0, pB1, t + 1, true, true, true);   FA_WAIT_BAR(2); RESC(); ROT();
    }
#define ENDW(tt) do { if ((tt) + 3 < NT) { FA_WAIT_BAR(2); } else if ((tt) + 2 < NT) { FA_WAIT_BAR(1); } else { FA_WAIT_BAR(0); } } while (0)
    for (; t + 1 < NT; t += 2) {
        STEP(pB0, pB1, pA0, pA1, t, (t + 3 < NT), (t + 1 < NT), (t + 1 < NT));         ENDW(t);     RESC(); ROT();
        STEP(pA0, pA1, pB0, pB1, t + 1, (t + 4 < NT), (t + 2 < NT), (t + 2 < NT));     ENDW(t + 1); RESC(); ROT();
    }
    STEP(pB0, pB1, pA0, pA1, NT - 1, false, false, false); RESC();
    { float sacc = pB0[0] + pB0[1]; _Pragma("unroll") for (int r = 2; r < 16; ++r) sacc += pB0[r]; _Pragma("unroll") for (int r = 0; r < 16; ++r) sacc += pB1[r]; l_reg += sacc;
      pw0 = (u32x4){PKW(pB0, 0), PKW(pB0, 2), PKW(pB0, 4), PKW(pB0, 6)}; pw1 = (u32x4){PKW(pB0, 8), PKW(pB0, 10), PKW(pB0, 12), PKW(pB0, 14)};
      pw2 = (u32x4){PKW(pB1, 0), PKW(pB1, 2), PKW(pB1, 4), PKW(pB1, 6)}; pw3 = (u32x4){PKW(pB1, 8), PKW(pB1, 10), PKW(pB1, 12), PKW(pB1, 14)};
      FA_SBAR(); pv(o, vp0 + sl_cur, PAF(0), PAF(1), PAF(2), PAF(3)); }
#undef PKW
#undef PAF
#undef VFR
#undef PIN
#undef MX3
#undef GAPA
#undef GAPB
#undef EX
#undef VRD
#undef KRD
#undef QK0
#undef QKN
#undef STEP
#undef ENDW
    { auto rr = __builtin_amdgcn_permlane32_swap(__float_as_uint(l_reg), __float_as_uint(l_reg), false, false); l_reg = __uint_as_float(rr[0]) + __uint_as_float(rr[1]); }
    if (hi == 0) wsf[32 + r32] = l_reg; asm volatile("s_waitcnt lgkmcnt(0)" ::: "memory");
#pragma unroll
    for (int r = 0; r < 16; ++r) { const float rl = __builtin_amdgcn_rcpf(wsf[32 + crow(r, hi)]); o[0][r] *= rl; o[1][r] *= rl; }
    asm volatile("s_waitcnt lgkmcnt(0)\n\ts_barrier" ::: "memory");
#undef DMA_K
#undef DMA_V
#undef CMASK
#undef START
#undef RESC
#undef ROT
}
}

namespace fa {
constexpr int KSL6 = 12288, LDS6_K = 0, LDS6_V = 3 * KSL6, LDS6_WS = LDS6_V + 3 * SLOTB;
struct Src6 { const bf16_t* K; int kp; const bf16_t* K2; int kp2; const bf16_t* V; int vp; };
template <int THRL>
__device__ __forceinline__ void unit6(f32x16 (&o)[2], const bf16x8 (&qr)[6], const Src6& src, int t_hi, int q0w, LAS unsigned char* shm, int wid, int lane) {
    const int r32 = lane & 31, hi = lane >> 5, qpos = q0w + r32;
    const unsigned lds0 = (unsigned)(uintptr_t)shm;
    LAS float* wsf = (LAS float*)(shm + LDS6_WS) + wid * 64;
    const bf16_t* ksrc = src.K + (size_t)lane * src.kp + wid * 8;
    const bf16_t* k2src = src.K2 + (size_t)lane * src.kp2 + (wid & 3) * 8;
    const bf16_t* vsrc = src.V + (size_t)(16 * (wid & 3) + (lane >> 2)) * src.vp + (wid >> 2) * 32 + (lane & 3) * 8;
    const unsigned kdst = lds0 + LDS6_K + wid * 1024, k2dst = lds0 + LDS6_K + (8 + (wid & 3)) * 1024, vdst = lds0 + LDS6_V + wid * 1024;
    const size_t ktile = (size_t)64 * src.kp, k2tile = (size_t)64 * src.kp2, vtile = (size_t)64 * src.vp;
#define DMA_K(t, slot) do { glds16(ksrc + (size_t)(t) * ktile, (unsigned)__builtin_amdgcn_readfirstlane(kdst + (slot))); glds16(k2src + (size_t)(t) * k2tile, (unsigned)__builtin_amdgcn_readfirstlane(k2dst + (slot))); } while (0)
#define DMA_V(t, slot) glds16(vsrc + (size_t)(t) * vtile, (unsigned)__builtin_amdgcn_readfirstlane(vdst + (slot)))
    const lds_cptr shm3 = (lds_cptr)shm; const lds_cptr kp0 = shm3 + LDS6_K + hi * 1024 + r32 * 16;
    const lds_cptr vp0 = shm3 + LDS6_V + ((lane >> 4) & 1) * 32 + (lane & 3) * 8 + (4 * hi + ((lane & 15) >> 2)) * 64;
    bf16x8 kf[12];
    const int NT = t_hi;
    DMA_K(0, 0); DMA_V(0, 0); DMA_K(1, KSL6);
    float mhat = 0.f, l_reg = 0.f; o[0] = f32x16{}; o[1] = f32x16{}; f32x16 negm = f32x16{}; asm volatile("" : "+v"(negm));
#define CMASK(P0, P1, t) do { if ((t) >= NT - 4) mask<0>(P0, P1, qpos - 4 * hi - (t) * 64, false); } while (0)
    bool resc = false;
#define START(P0, P1) do { const float rm = rowmax(P0, P1); resc = false; \
    { const float dl = rm > -1e30f ? rm : 0.f; mhat = fadd_s(mhat, dl); \
      _Pragma("unroll") for (int r = 0; r < 16; ++r) { P0[r] = fsub_s(P0[r], dl); P1[r] = fsub_s(P1[r], dl); } \
      _Pragma("unroll") for (int r = 0; r < 16; ++r) negm[r] = -mhat; asm volatile("" : "+v"(negm)); } \
    _Pragma("unroll") for (int r = 0; r < 16; ++r) P0[r] = __builtin_amdgcn_exp2f(P0[r]); } while (0)
#define RESC() do { if (resc) { asm volatile("s_waitcnt lgkmcnt(0)" ::: "memory"); \
      _Pragma("unroll") for (int d_ = 0; d_ < 2; ++d_) _Pragma("unroll") for (int r = 0; r < 16; ++r) o[d_][r] *= wsf[crow(r, hi)]; } } while (0)
    f32x16 pA0, pA1, pB0, pB1;
    int kprev = 0, kcur = 0, knext = KSL6, vprev = 0, vcur = 0, vnext = SLOTB;
#define ROT() do { kprev = kcur; kcur = knext; knext = (knext == 2 * KSL6) ? 0 : knext + KSL6; vprev = vcur; vcur = vnext; vnext = (vnext == 2 * SLOTB) ? 0 : vnext + SLOTB; } while (0)
    DMA_K(2, 2 * KSL6);
    FA_WAIT_BAR(5);
    qkt<6>(pA0, pA1, shm3 + LDS6_K, qr, negm, r32, hi); asm volatile("s_nop 15\n\ts_nop 7" : "+v"(pA0), "+v"(pA1)); CMASK(pA0, pA1, 0);
    START(pA0, pA1);
    _Pragma("unroll") for (int r = 0; r < 16; ++r) pA1[r] = __builtin_amdgcn_exp2f(pA1[r]);
    FA_WAIT_BAR(0);
    DMA_K(3, 0); DMA_V(1, SLOTB);
    ROT();
    kloadall<6>(kf, kp0 + kcur);
    FA_WAIT_BAR(3);
    u32x4 pw0, pw1, pw2, pw3;
#define PKW(P, B) cvtpk(P[B], P[B + 1])
#define PAF(k) __builtin_bit_cast(bf16x8, pw##k)
#define PIN(x) asm volatile("" : "+v"(x))
#define MX3(a, b, c) __builtin_fmaxf(__builtin_fmaxf((a), (b)), (c))
#define GAPA(MF, A0, A1, A2, A3, W0, W1, PW) do { MF; sacc += A0; sacc += A1; sacc += A2; sacc += A3; PIN(sacc); W0; W1; PIN(PW); FA_SBAR(); } while (0)
#define EX(v) __builtin_amdgcn_exp2f(v)
#define VLD(i) const s16x4 vl##i = vtr(vp_ + (((i) >> 2) * 4096 + ((i) & 3) * 1024)), vh##i = vtr(vp_ + (((i) >> 2) * 4096 + ((i) & 3) * 1024 + 512))
#define VFR(i) (bf16x8){vl##i[0], vl##i[1], vl##i[2], vl##i[3], vh##i[0], vh##i[1], vh##i[2], vh##i[3]}
#define GAPB(MF, X, B) do { MF; X[B] = EX(X[B]); X[B + 1] = EX(X[B + 1]); X[B + 2] = EX(X[B + 2]); X[B + 3] = EX(X[B + 3]); PIN(X); FA_SBAR(); } while (0)
#define KRD(G, j) do { if (G) { kload2(kf, kp0 + knext, j); FA_SBAR(); } } while (0)
#define QK(C, kidx, qidx) C = __builtin_amdgcn_mfma_f32_32x32x16_bf16(kf[kidx], qr[qidx], C, 0, 0, 0)
#define STEP(C0, C1, P0, P1, t, GK, GV, GL) do { FA_SBAR(); \
    float sacc = (P0[0] + P0[1]); \
    GAPA(C0 = __builtin_amdgcn_mfma_f32_32x32x16_bf16(kf[0], qr[0], negm, 0, 0, 0), P0[2], P0[3], P0[4], P0[5],     pw0[0] = PKW(P0, 0), pw0[1] = PKW(P0, 2), pw0); \
    GAPA(C1 = __builtin_amdgcn_mfma_f32_32x32x16_bf16(kf[1], qr[0], negm, 0, 0, 0), P0[6], P0[7], P0[8], P0[9],     pw0[2] = PKW(P0, 4), pw0[3] = PKW(P0, 6), pw0); \
    GAPA(QK(C0, 2, 1),   P0[10], P0[11], P0[12], P0[13], pw1[0] = PKW(P0, 8), pw1[1] = PKW(P0, 10), pw1); \
    GAPA(QK(C1, 3, 1),   P0[14], P0[15], P1[0], P1[1],   pw1[2] = PKW(P0, 12), pw1[3] = PKW(P0, 14), pw1); \
    GAPA(QK(C0, 4, 2),   P1[2], P1[3], P1[4], P1[5],     pw2[0] = PKW(P1, 0), pw2[1] = PKW(P1, 2), pw2); \
    GAPA(QK(C1, 5, 2),   P1[6], P1[7], P1[8], P1[9],     pw2[2] = PKW(P1, 4), pw2[3] = PKW(P1, 6), pw2); \
    GAPA(QK(C0, 6, 3),   P1[10], P1[11], P1[12], P1[13], pw3[0] = PKW(P1, 8), pw3[1] = PKW(P1, 10), pw3); \
    GAPA(QK(C1, 7, 3),   P1[14], P1[15], 0.f, 0.f,       pw3[2] = PKW(P1, 12), pw3[3] = PKW(P1, 14), pw3); \
    QK(C0, 8, 4); QK(C1, 9, 4); QK(C0, 10, 5); QK(C1, 11, 5); FA_SBAR(); \
    l_reg += sacc; \
    if (GK) { DMA_K((t) + 3, kcur); } if (GV) { DMA_V((t) + 1, vnext); } \
    const lds_cptr vp_ = vp0 + vprev; \
    VLD(0); VLD(4); FA_SBAR(); \
    CMASK(C0, C1, t); \
    { float a = MX3(C0[0], C0[1], C1[0]), b = MX3(C0[2], C0[3], C1[1]); a = MX3(a, C1[2], C1[3]); \
      _Pragma("unroll") for (int r = 4; r < 16; r += 4) { a = MX3(a, C0[r], C0[r + 1]); b = MX3(b, C0[r + 2], C0[r + 3]); a = MX3(a, C1[r], C1[r + 1]); b = MX3(b, C1[r + 2], C1[r + 3]); } \
      float rm = __builtin_fmaxf(a, b); { auto rr = __builtin_amdgcn_permlane32_swap(__float_as_uint(rm), __float_as_uint(rm), false, false); rm = __builtin_fmaxf(__uint_as_float(rr[0]), __uint_as_float(rr[1])); } \
      resc = false; \
      if (__builtin_expect(__any(rm > (float)THRL), 0)) { const float dl = __builtin_fmaxf(rm, 0.f); mhat += dl; \
        _Pragma("unroll") for (int r = 0; r < 16; ++r) { C0[r] -= dl; C1[r] -= dl; } \
        _Pragma("unroll") for (int r = 0; r < 16; ++r) negm[r] = -mhat; asm volatile("" : "+v"(negm)); \
        const float f = __builtin_amdgcn_exp2f(-dl); l_reg *= f; { int l2_ = lane; asm volatile("" : "+v"(l2_)); if (l2_ < 32) wsf[l2_] = f; } resc = true; } } \
    FA_SBAR(); \
    VLD(1); FA_SBAR(); GAPB(o[0] = __builtin_amdgcn_mfma_f32_32x32x16_bf16(PAF(0), VFR(0), o[0], 0, 0, 0), C0, 0); \
    VLD(5); KRD(GL, 0); GAPB(o[1] = __builtin_amdgcn_mfma_f32_32x32x16_bf16(PAF(0), VFR(4), o[1], 0, 0, 0), C0, 4); \
    VLD(2); KRD(GL, 1); GAPB(o[0] = __builtin_amdgcn_mfma_f32_32x32x16_bf16(PAF(1), VFR(1), o[0], 0, 0, 0), C0, 8); \
    VLD(6); KRD(GL, 2); GAPB(o[1] = __builtin_amdgcn_mfma_f32_32x32x16_bf16(PAF(1), VFR(5), o[1], 0, 0, 0), C0, 12); \
    VLD(3); KRD(GL, 3); GAPB(o[0] = __builtin_amdgcn_mfma_f32_32x32x16_bf16(PAF(2), VFR(2), o[0], 0, 0, 0), C1, 0); \
    VLD(7); KRD(GL, 4); GAPB(o[1] = __builtin_amdgcn_mfma_f32_32x32x16_bf16(PAF(2), VFR(6), o[1], 0, 0, 0), C1, 4); \
    KRD(GL, 5); GAPB(o[0] = __builtin_amdgcn_mfma_f32_32x32x16_bf16(PAF(3), VFR(3), o[0], 0, 0, 0), C1, 8); \
    GAPB(o[1] = __builtin_amdgcn_mfma_f32_32x32x16_bf16(PAF(3), VFR(7), o[1], 0, 0, 0), C1, 12); \
    } while (0)
    int t = 1;
    for (; t + 5 < NT; t += 2) {
        STEP(pB0, pB1, pA0, pA1, t, true, true, true);       FA_WAIT_BAR(3); RESC(); ROT();
        STEP(pA0, pA1, pB0, pB1, t + 1, true, true, true);   FA_WAIT_BAR(3); RESC(); ROT();
    }
#define ENDW(tt) do { if ((tt) + 3 < NT) { FA_WAIT_BAR(3); } else if ((tt) + 2 < NT) { FA_WAIT_BAR(1); } else { FA_WAIT_BAR(0); } } while (0)
    for (; t + 1 < NT; t += 2) {
        STEP(pB0, pB1, pA0, pA1, t, (t + 3 < NT), (t + 1 < NT), (t + 1 < NT));         ENDW(t);     RESC(); ROT();
        STEP(pA0, pA1, pB0, pB1, t + 1, (t + 4 < NT), (t + 2 < NT), (t + 2 < NT));     ENDW(t + 1); RESC(); ROT();
    }
    STEP(pB0, pB1, pA0, pA1, NT - 1, false, false, false); RESC();
    { float sacc = pB0[0] + pB0[1]; _Pragma("unroll") for (int r = 2; r < 16; ++r) sacc += pB0[r]; _Pragma("unroll") for (int r = 0; r < 16; ++r) sacc += pB1[r]; l_reg += sacc;
      pw0 = (u32x4){PKW(pB0, 0), PKW(pB0, 2), PKW(pB0, 4), PKW(pB0, 6)}; pw1 = (u32x4){PKW(pB0, 8), PKW(pB0, 10), PKW(pB0, 12), PKW(pB0, 14)};
      pw2 = (u32x4){PKW(pB1, 0), PKW(pB1, 2), PKW(pB1, 4), PKW(pB1, 6)}; pw3 = (u32x4){PKW(pB1, 8), PKW(pB1, 10), PKW(pB1, 12), PKW(pB1, 14)};
      FA_SBAR(); pv(o, vp0 + vcur, PAF(0), PAF(1), PAF(2), PAF(3)); }
#undef PKW
#undef PAF
#undef VFR
#undef VLD
#undef PIN
#undef MX3
#undef GAPA
#undef GAPB
#undef EX
#undef KRD
#undef QK
#undef STEP
#undef ENDW
    { auto rr = __builtin_amdgcn_permlane32_swap(__float_as_uint(l_reg), __float_as_uint(l_reg), false, false); l_reg = __uint_as_float(rr[0]) + __uint_as_float(rr[1]); }
    if (hi == 0) wsf[32 + r32] = l_reg; asm volatile("s_waitcnt lgkmcnt(0)" ::: "memory");
#pragma unroll
    for (int r = 0; r < 16; ++r) { const float rl = __builtin_amdgcn_rcpf(wsf[32 + crow(r, hi)]); o[0][r] *= rl; o[1][r] *= rl; }
    asm volatile("s_waitcnt lgkmcnt(0)\n\ts_barrier" ::: "memory");
#undef DMA_K
#undef DMA_V
#undef CMASK
#undef START
#undef RESC
#undef ROT
}
}

struct Args { const void* in[29]; float* out; unsigned char* ws; int ph_lo, ph_hi; };
struct Ctx {
    LAS unsigned char* lds; int tid, lane, wave, G, bid;
    const void* const* in; float* X; unsigned char* ws;
    __device__ __forceinline__ const float* fin(int i, size_t layer_stride, int l) const { const __attribute__((address_space(1))) float* p = (const __attribute__((address_space(1))) float*)in[i]; asm volatile("" : "+s"(p)); return (const float*)p + layer_stride * (size_t)l; }
    template <class Tp> __device__ __forceinline__ Tp* w(size_t off) const { return (Tp*)(ws + off); }
};
constexpr size_t NKV_STRIDE = (size_t)8 * T * 64;

struct Src { const float* p; int ld, koff, klen; const float* gain; float cs; };
__device__ __forceinline__ Src get_src(const Ctx& c, int l, int mat, int n) {
    Src s; s.p = nullptr; s.ld = 0; s.koff = 0; s.klen = 0; s.gain = nullptr; s.cs = 1.f;
    switch (mat) {
    case 0: { s.p = (((n >> 2) & 1) ? c.fin(4, (size_t)D * FF, l) : c.fin(3, (size_t)D * FF, l)) + ((n >> 8) * 128 + ((n >> 5) & 3) * 32 + ((n >> 3) & 3) * 8 + ((n >> 7) & 1) * 4 + (n & 3)); s.ld = FF; s.klen = D; s.gain = c.fin(2, D, l); } break;
    case 5: { s.p = (((n >> 2) & 1) ? c.fin(26, (size_t)D * FF, l) : c.fin(25, (size_t)D * FF, l)) + ((n >> 8) * 128 + ((n >> 5) & 3) * 32 + ((n >> 3) & 3) * 8 + ((n >> 7) & 1) * 4 + (n & 3)); s.ld = FF; s.klen = D; s.gain = c.fin(24, D, l); } break;
    case 1: { s.p = c.fin(5, (size_t)FF * D, l) + n; s.ld = D; s.klen = FF; } break;
    case 6: { s.p = c.fin(27, (size_t)FF * D, l) + n; s.ld = D; s.klen = FF; } break;
    case 2: { int oc = -1; if (n < 1504) oc = n; else if (n < 2272) oc = n + 18; else if (n < 2290) oc = 1504 + (n - 2272);
              if (oc >= 0) { s.p = c.fin(7, (size_t)D * 2290, l) + oc; s.ld = 2290; s.klen = D; s.gain = c.fin(6, D, l); }
              s.cs = (n >= 352 && n < 736) ? QSC_B : (n >= 1504 && n < 1760) ? QSC_C : 1.f; } break;
    case 3: { if (n < 384) { s.p = c.fin(10, 192 * 576, l) + (n >> 6) * 96 + (n & 63); s.ld = 576; s.klen = 192; s.gain = c.fin(8, 192, l); }
              else if (n < 576) { const int m = n - 384; s.p = c.fin(10, 192 * 576, l) + (m >> 5) * 96 + 64 + (m & 31); s.ld = 576; s.klen = 192; s.gain = c.fin(8, 192, l); }
              else if (n < 768) { }
              else if (n < 1152) { const int m = n - 768; s.p = c.fin(11, 128 * 768, l) + (m >> 6) * 128 + (m & 63); s.ld = 768; s.koff = 192; s.klen = 128; s.gain = c.fin(9, 128, l); }
              else { const int m = n - 1152; s.p = c.fin(11, 128 * 768, l) + (m >> 6) * 128 + 64 + (m & 63); s.ld = 768; s.koff = 192; s.klen = 128; s.gain = c.fin(9, 128, l); } } break;
    case 4: { s.p = c.fin(23, (size_t)D * D, l) + n; s.ld = D; s.klen = D; } break;
    case 7: { s.p = c.fin(14, 2048 * 64, l) + n; s.ld = 64; s.klen = 2048; } break;
    case 8: { s.p = c.fin(16, 2048 * 64, l) + n; s.ld = 64; s.klen = 2048; } break;
    case 9: { s.p = c.fin(15, 64 * 64, l) + n; s.ld = 64; s.klen = 64; } break;
    default: { s.p = c.fin(17, 64 * 64, l) + n; s.ld = 64; s.klen = 64; } break;
    }
    return s;
}
__device__ __forceinline__ void conv_item(const Ctx& c, int l, int mat, int item, LAS float* scr) {
    int N, K; size_t off;
    switch (mat) {
    case 0: N = 5632; K = 1024; off = WS_W1A; break;   case 1: N = 1024; K = 2816; off = WS_W1D; break;
    case 2: N = 2304; K = 1024; off = WS_WIN; break;   case 3: N = 1536; K = 384; off = WS_WMLA; break;
    case 4: N = 1024; K = 1024; off = WS_WOUT; break;  case 5: N = 5632; K = 1024; off = WS_W2A; break;
    case 6: N = 1024; K = 2816; off = WS_W2D; break;   case 7: N = 64; K = 2048; off = WS_W1KT; break;
    case 8: N = 64; K = 2048; off = WS_W1VT; break;    case 9: N = 64; K = 64; off = WS_W2KT; break;
    default: N = 64; K = 64; off = WS_W2VT; break;
    }
    bf16_t* dst = c.w<bf16_t>(off);
    const int lane = c.lane, nblk = N / 32, kb = item / nblk, nb = item % nblk, k0 = 64 * kb, n0 = 32 * nb;
    const Src s = get_src(c, l, mat, n0 + (lane & 31));
    float vv[32], gg[32];
    const bool has = s.p != nullptr, hasg = s.gain != nullptr;
#pragma unroll
    for (int i = 0; i < 32; ++i) {
        const int ks = k0 + 2 * i + (lane >> 5) - s.koff; const bool ok = has && ks >= 0 && ks < s.klen;
        vv[i] = ok ? __builtin_nontemporal_load(s.p + (size_t)ks * s.ld) : 0.f; gg[i] = (ok && hasg) ? s.gain[ks] : 1.f;
    }
#pragma unroll
    for (int i = 0; i < 32; ++i) scr[(2 * i + (lane >> 5)) * 33 + (lane & 31)] = vv[i] * gg[i] * s.cs;
    const int c8 = lane & 7;
#pragma unroll
    for (int j = 0; j < 4; ++j) {
        const int nn = (lane >> 3) + 8 * j; const LAS float* sp = scr + (8 * c8) * 33 + nn;
        u32x4 o; o.x = cvtpk(sp[0 * 33], sp[1 * 33]); o.y = cvtpk(sp[2 * 33], sp[3 * 33]); o.z = cvtpk(sp[4 * 33], sp[5 * 33]); o.w = cvtpk(sp[6 * 33], sp[7 * 33]);
        *(u32x4*)(dst + (size_t)(n0 + nn) * K + k0 + 8 * c8) = o;
    }
}
__device__ __forceinline__ void convert_set(const Ctx& c, int l, int set, int wg0, int nwg) {
    if (c.bid < wg0 || c.bid >= wg0 + nwg) return;
    LAS float* scr = (LAS float*)(c.lds + c.wave * 8448);
    const int gw = (c.bid - wg0) * 8 + c.wave, NGW = nwg * 8;
    if (set == 0) {
        for (int it = gw; it < 2816; it += NGW) conv_item(c, l, 0, it, scr);
    } else if (set == 2) {
        constexpr int total = 1408 + 1152 + 288 + 64 + 64 + 2 + 2;
        for (int it = gw; it < total; it += NGW) {
            int r = it, mat;
            if (r < 1408) mat = 1; else if ((r -= 1408) < 1152) mat = 2; else if ((r -= 1152) < 288) mat = 3;
            else if ((r -= 288) < 64) mat = 7; else if ((r -= 64) < 64) mat = 8; else if ((r -= 64) < 2) mat = 9; else { r -= 2; mat = 10; }
            conv_item(c, l, mat, r, scr);
        }
    } else {
        constexpr int total = 512 + 2816 + 1408;
        for (int it = gw; it < total; it += NGW) {
            int r = it, mat;
            if (r < 512) mat = 4; else if ((r -= 512) < 2816) mat = 5; else { r -= 2816; mat = 6; }
            conv_item(c, l, mat, r, scr);
        }
    }
}

__device__ __forceinline__ void rope_tables(const Ctx& c, int wg0, int nwg) {
    if (c.bid < wg0 || c.bid >= wg0 + nwg) return;
    LAS float* invf = (LAS float*)(c.lds + 72 * 1024);
    if (c.tid < 28) { const int j = c.tid; int jj, half; if (j < 16) { jj = j; half = 16; } else if (j < 24) { jj = j - 16; half = 8; } else { jj = j - 24; half = 4; }
        const float e = (float)(2 * jj) / (float)(2 * half);
        const float pw = (float)pow(500000.0, (double)e); invf[j] = 1.0f / pw; }
    __syncthreads();
    const int* pos = (const int*)c.in[1];
    float* tA = c.w<float>(WS_TABA); float* tB = c.w<float>(WS_TABB); float* tC = c.w<float>(WS_TABC);
    for (int idx = (c.bid - wg0) * 512 + c.tid; idx < M * 28; idx += nwg * 512) {
        const int row = idx / 28, j = idx % 28; const int jj = j < 16 ? j : j < 24 ? j - 16 : j - 24;
        const float ang = (float)pos[row] * invf[j];
        double rev = (double)ang * 0.15915494309189535; rev -= rint(rev);
        const float rf = (float)rev; const float cs = __builtin_amdgcn_cosf(rf), sn = __builtin_amdgcn_sinf(rf);
        if (j < 16) { tA[row * 32 + jj] = cs; tA[row * 32 + 16 + jj] = sn; } else if (j < 24) { tB[row * 16 + jj] = cs; tB[row * 16 + 8 + jj] = sn; } else { tC[row * 8 + jj] = cs; tC[row * 8 + 4 + jj] = sn; }
    }
}
__device__ __forceinline__ void prologue(const Ctx& c) {
    convert_set(c, 0, 0, 0, c.G); if (c.G != 256) convert_set(c, 0, 2, 0, c.G); rope_tables(c, 0, c.G);
    const int gw = c.bid * 8 + c.wave, NGW = c.G * 8, lane = c.lane;
    const float* x = (const float*)c.in[0]; bf16_t* XB = c.w<bf16_t>(WS_XB); float* part = c.w<float>(WS_PART);
    for (int rb = gw; rb < M; rb += 4 * NGW) {
        f32x4 v[4][4];
#pragma unroll
        for (int q = 0; q < 4; ++q) { int row = rb + q * NGW; row = row < M ? row : M - 1; const f32x4* xr = (const f32x4*)(x + (size_t)row * D) + lane;
#pragma unroll
            for (int j = 0; j < 4; ++j) v[q][j] = __builtin_nontemporal_load(xr + 64 * j); }
#pragma unroll
        for (int q = 0; q < 4; ++q) { const int row = rb + q * NGW; if (row >= M) break;
            u32x2* br = (u32x2*)(XB + (size_t)row * D) + lane; float ss = 0.f;
#pragma unroll
            for (int j = 0; j < 4; ++j) { const f32x4 t = v[q][j]; u32x2 w; w.x = cvtpk(t.x, t.y); w.y = cvtpk(t.z, t.w); br[64 * j] = w; ss += (t.x * t.x + t.y * t.y) + (t.z * t.z + t.w * t.w); }
            ss = wave_sum(ss);
            if (lane < 16) part[(size_t)row * 16 + lane] = lane == 0 ? ss : 0.f; }
    }
    float* misc = c.w<float>(WS_MISC);
    for (int o = gw; o < NL * 2 * 64; o += NGW) {
        const int n = o & 63, which = (o >> 6) & 1, l = o >> 7;
        const float* pe = which ? c.fin(13, 2048, l) : c.fin(12, 2048, l); const float* w1 = which ? c.fin(16, 2048 * 64, l) : c.fin(14, 2048 * 64, l);
        float s = 0.f; for (int k = lane; k < 2048; k += 64) s += pe[k] * w1[(size_t)k * 64 + n];
        s = wave_sum(s); if (lane == 0) misc[o] = s;
    }
    if (c.bid == 0 && c.wave < NL) {
        const int l = c.wave; const int i = lane & 31;
        float a = c.fin(18, 32, l)[i] * c.fin(19, 32, l)[i], b = c.fin(20, 32, l)[i] * c.fin(21, 32, l)[i];
        a = wave_sum(a) * 0.5f; b = wave_sum(b) * 0.5f;
        const float lam_init = 0.8f - 0.6f * expf(-0.3f * (float)l);
        if (lane == 0) { misc[512 + l] = expf(a) - expf(b) + lam_init; misc[512 + NL + l] = lam_init; }
    }
}

__device__ __forceinline__ void ld8(const bf16_t* p, float (&f)[8]) { const u32x4 w = *(const u32x4*)p; f[0] = bflo(w.x); f[1] = bfhi(w.x); f[2] = bflo(w.y); f[3] = bfhi(w.y); f[4] = bflo(w.z); f[5] = bfhi(w.z); f[6] = bflo(w.w); f[7] = bfhi(w.w); }
__device__ __forceinline__ void st8(bf16_t* p, const float (&f)[8]) { u32x4 w; w.x = cvtpk(f[0], f[1]); w.y = cvtpk(f[2], f[3]); w.z = cvtpk(f[4], f[5]); w.w = cvtpk(f[6], f[7]); *(u32x4*)p = w; }
__device__ __forceinline__ void up8(const u32x4 w, float (&f)[8]) { f[0] = bflo(w.x); f[1] = bfhi(w.x); f[2] = bflo(w.y); f[3] = bfhi(w.y); f[4] = bflo(w.z); f[5] = bfhi(w.z); f[6] = bflo(w.w); f[7] = bfhi(w.w); }
__device__ __forceinline__ void prep_phase(const Ctx& c) {
    const int gw = c.bid * 8 + c.wave, NGW = c.G * 8, lane = c.lane;
    const bf16_t* H = c.w<bf16_t>(WS_H); const bf16_t* CQ = c.w<bf16_t>(WS_OCMP); bf16_t* KPE = c.w<bf16_t>(WS_KPE); bf16_t* QN = c.w<bf16_t>(WS_QN); bf16_t* NKV = c.w<bf16_t>(WS_NKV);
    bf16_t* DQ = c.w<bf16_t>(WS_DQ); bf16_t* DKb = c.w<bf16_t>(WS_DK); float* gates = c.w<float>(WS_GATES);
    const float* tA = c.w<float>(WS_TABA); const float* tB = c.w<float>(WS_TABB); const float* tC = c.w<float>(WS_TABC);
    float* rsq = c.w<float>(WS_RSQ); float* rskv = c.w<float>(WS_RSKV);
    int role, chA, chB;
    if (lane < 20) { role = 0; chA = 2 * lane; chB = chA + 1; }
    else if (lane < 22) { role = 1; chA = 20 + lane; chB = chA + 2; }
    else if (lane < 28) { role = 2; chA = 44 + 8 * (lane - 22); chB = chA + 1; }
    else if (lane < 34) { role = 3; const int i = lane - 28; chA = 92 + 32 * (i >> 1) + 8 * (i & 1); chB = chA + 1; }
    else if (lane < 50) { role = 4; chA = 188 + 4 * (lane - 34); chB = chA; }
    else if (lane < 53) { role = 5; chA = 284 + (lane - 50); chB = chA; }
    else { role = 6; chA = 284; chB = 284; }
    const bf16_t* sb = role < 2 ? CQ : H; const int sld = role < 2 ? 384 : HW;
    const float* tcp; const float* tsp; int tld;
    if (role == 1) { tcp = tA + (lane == 21 ? 8 : 0); tsp = tcp + 16; tld = 32; }
    else if (role == 2 || role == 3) { tcp = tB; tsp = tB + 8; tld = 16; }
    else { tcp = tC; tsp = tC; tld = 8; }
    for (int rb = gw; rb < M; rb += 4 * NGW) {
        u32x4 hv[4], pv[4]; f32x4 cv[4][2], sv[4][2];
#pragma unroll
        for (int q = 0; q < 4; ++q) { int row = rb + q * NGW; row = row < M ? row : M - 1;
            hv[q] = *(const u32x4*)(sb + (size_t)row * sld + chA * 8); pv[q] = *(const u32x4*)(sb + (size_t)row * sld + chB * 8);
            const f32x4* a = (const f32x4*)(tcp + (size_t)row * tld); const f32x4* b2 = (const f32x4*)(tsp + (size_t)row * tld);
            cv[q][0] = a[0]; cv[q][1] = a[1]; sv[q][0] = b2[0]; sv[q][1] = b2[1]; }
#pragma unroll
        for (int q = 0; q < 4; ++q) {
            const int row = rb + q * NGW; if (row >= M) break;
            const int b = row / T, t = row % T;
            float f[8], g2[8]; up8(hv[q], f); up8(pv[q], g2);
            const float cs[8] = {cv[q][0].x, cv[q][0].y, cv[q][0].z, cv[q][0].w, cv[q][1].x, cv[q][1].y, cv[q][1].z, cv[q][1].w};
            const float sn[8] = {sv[q][0].x, sv[q][0].y, sv[q][0].z, sv[q][0].w, sv[q][1].x, sv[q][1].y, sv[q][1].z, sv[q][1].w};
            float sq = 0.f, skv = 0.f;
            if (role == 0) { float s2 = 0.f;
#pragma unroll
                for (int j = 0; j < 8; ++j) s2 += f[j] * f[j] + g2[j] * g2[j];
                if (lane < 12) sq = s2; else skv = s2; }
            else if (role <= 3) { float o1[8], o2[8];
#pragma unroll
                for (int j = 0; j < 8; ++j) { o1[j] = f[j] * cs[j] - g2[j] * sn[j]; o2[j] = f[j] * sn[j] + g2[j] * cs[j]; }
                bf16_t* d1; bf16_t* d2;
                if (role == 1) { d1 = KPE + (size_t)row * 32 + (lane - 20) * 8; d2 = d1 + 16; }
                else if (role == 2) { d1 = QN + (size_t)row * 384 + (chA - 44) * 8; d2 = d1 + 8; }
                else { const int i = lane - 28, buf = 2 * (i >> 1), g = i & 1; d1 = NKV + (size_t)buf * NKV_STRIDE + ((size_t)(b * 2 + g) * T + t) * 64; d2 = d1 + 8; }
                st8(d1, o1); st8(d2, o2); }
            else if (role == 4) { const int e = chA - 188; float o1[8];
#pragma unroll
                for (int j = 0; j < 4; ++j) { o1[j] = f[j] * cs[j] - f[j + 4] * cs[4 + j]; o1[j + 4] = f[j] * cs[4 + j] + f[j + 4] * cs[j]; }
                st8((e < 32 ? DQ + (size_t)row * 256 + e * 8 : DKb + (size_t)row * 256 + (e - 32) * 8), o1); }
            else if (role == 5) { const int j0 = (chA - 284) * 8;
#pragma unroll
                for (int j = 0; j < 8; ++j) if (j0 + j < 18) gates[(size_t)row * 18 + j0 + j] = frcp(1.f + fexp2(-f[j] * LOG2E)); }
            sq = wave_sum(sq); skv = wave_sum(skv);
            if (lane == 0) { rsq[row] = rsqrtf(sq * (1.f / 192.f) + EPS); rskv[row] = rsqrtf(skv * (1.f / 128.f) + EPS); }
        }
    }
}

__device__ __forceinline__ void compress_unit(const Ctx& c, int l, int unit) {
    const int which = unit & 1, ct = (unit >> 1) & 7, bg = unit >> 4;
    const int wid = c.wave, lane = c.lane, r32 = lane & 31, hi = lane >> 5;
    const bf16_t* src = c.w<bf16_t>(WS_NKV) + (size_t)which * NKV_STRIDE + (size_t)bg * T * 64;
    const bf16_t* w1t = c.w<bf16_t>(which ? WS_W1VT : WS_W1KT); const bf16_t* w2t = c.w<bf16_t>(which ? WS_W2VT : WS_W2KT);
    const float* bias = c.w<float>(WS_MISC) + (l * 2 + which) * 64; bf16_t* dst = c.w<bf16_t>(which ? WS_VCMP : WS_KCMP);
    const int c0 = ct * 32; int cc = c0 + r32; if (cc > 254) cc = 254;
    const bf16_t* arow = src + (size_t)cc * 1024 + wid * 256 + hi * 8;
    f32x16 acc[2]; att::zero_o(acc);
#pragma unroll
    for (int half = 0; half < 2; ++half) {
        bf16x8 af[8], b0[8], b1[8];
#pragma unroll
        for (int k8 = 0; k8 < 8; ++k8) { const int ks = half * 8 + k8; af[k8] = *(const bf16x8*)(arow + ks * 16);
            b0[k8] = *(const bf16x8*)(w1t + (size_t)r32 * 2048 + wid * 256 + ks * 16 + hi * 8); b1[k8] = *(const bf16x8*)(w1t + (size_t)(32 + r32) * 2048 + wid * 256 + ks * 16 + hi * 8); }
#pragma unroll
        for (int k8 = 0; k8 < 8; ++k8) { acc[0] = __builtin_amdgcn_mfma_f32_32x32x16_bf16(af[k8], b0[k8], acc[0], 0, 0, 0); acc[1] = __builtin_amdgcn_mfma_f32_32x32x16_bf16(af[k8], b1[k8], acc[1], 0, 0, 0); }
    }
    LAS float* red = (LAS float*)c.lds; LAS bf16_t* hid = (LAS bf16_t*)(c.lds + 65536);
#pragma unroll
    for (int jh = 0; jh < 2; ++jh)
#pragma unroll
        for (int r = 0; r < 16; ++r) red[((wid * 2 + jh) * 16 + r) * 64 + lane] = acc[jh][r];
    __syncthreads();
    if (wid < 2) {
        const int jh = wid; const float bj = bias[jh * 32 + r32];
#pragma unroll
        for (int r = 0; r < 16; ++r) { float s = 0.f;
#pragma unroll
            for (int w = 0; w < 8; ++w) s += red[((w * 2 + jh) * 16 + r) * 64 + lane];
            hid[att::crow(r, hi) * 72 + jh * 32 + r32] = f2bf(silu_f(s + bj)); }
    }
    __syncthreads();
    if (wid < 2) {
        const int nh = wid; f32x16 a2 = (f32x16){0.f, 0.f, 0.f, 0.f, 0.f, 0.f, 0.f, 0.f, 0.f, 0.f, 0.f, 0.f, 0.f, 0.f, 0.f, 0.f};
#pragma unroll
        for (int s4 = 0; s4 < 4; ++s4) { const bf16x8 a = *(const LAS bf16x8*)(hid + r32 * 72 + s4 * 16 + hi * 8); const bf16x8 bb = *(const bf16x8*)(w2t + (size_t)(nh * 32 + r32) * 64 + s4 * 16 + hi * 8);
            a2 = __builtin_amdgcn_mfma_f32_32x32x16_bf16(a, bb, a2, 0, 0, 0); }
#pragma unroll
        for (int r = 0; r < 16; ++r) { const int ci = c0 + att::crow(r, hi); dst[((size_t)bg * 256 + ci) * 64 + nh * 32 + r32] = f2bf(ci < 255 ? a2[r] : 0.f); }
    }
    __syncthreads();
}

__device__ __forceinline__ void store_tile_wide(LAS unsigned char* stg_base, int wave_slot, const float (&v)[2][16], bf16_t* dst, int pitch, int lane) {
    const int r32 = lane & 31, hi = lane >> 5;
    LAS bf16_t* stg = (LAS bf16_t*)(stg_base + wave_slot * 4096);
#pragma unroll
    for (int r = 0; r < 16; ++r) { const int orow = att::crow(r, hi); stg[orow * 64 + r32] = f2bf(v[0][r]); stg[orow * 64 + 32 + r32] = f2bf(v[1][r]); }
#pragma unroll
    for (int i = 0; i < 4; ++i) { const int row = i * 8 + (lane >> 3), ch = lane & 7; const u32x4 w = *(const LAS u32x4*)(stg + row * 64 + ch * 8); *(u32x4*)(dst + (size_t)row * pitch + ch * 8) = w; }
}
constexpr int ATT_STG_OFF = 65536;
constexpr int CMP_STG_OFF = 116736;

constexpr int CMP_K = 0, CMP_V = 32768, CMP_IMP = 65536, CMP_SEL = 65536 + 6 * 8320;
__device__ __forceinline__ void cmp_mask(f32x16& p0, f32x16& p1, int cb, int t) {
#pragma unroll
    for (int r = 0; r < 16; ++r) { const int cidx = cb + (r & 3) + 8 * (r >> 2); if (16 * cidx + 31 > t) p0[r] = -INFINITY; if (16 * (cidx + 32) + 31 > t) p1[r] = -INFINITY; }
}
__device__ __forceinline__ void imp_update(LAS float* impL, const f32x16& P, int blk, float& prev_y3, int hi) {
    float y[4];
#pragma unroll
    for (int k = 0; k < 4; ++k) y[k] = __shfl_xor(P[4 * k + 3], 32);
#pragma unroll
    for (int k = 0; k < 4; ++k) {
        const float s4 = (P[4 * k] + P[4 * k + 1]) + (P[4 * k + 2] + P[4 * k + 3]);
        const float ex = hi ? y[k] : (k >= 1 ? y[k - 1] : prev_y3);
        impL[2 * k + 8 * blk] += s4 + ex;
    }
    prev_y3 = y[3];
}
__device__ __forceinline__ void cmp_unit(const Ctx& c, int w) {
    const int bg = w >> 5, jb = w & 31, b = bg >> 1, g = bg & 1;
    const int wid = c.wave, lane = c.lane, r32 = lane & 31, hi = lane >> 5;
    const int nct = ((63 - jb) * 64 + 32) / 1024 + 1;
    const bf16_t* KC = c.w<bf16_t>(WS_KCMP) + (size_t)bg * 256 * 64; const bf16_t* VC = c.w<bf16_t>(WS_VCMP) + (size_t)bg * 256 * 64;
    LAS unsigned char* lds = c.lds;
#pragma unroll 1
    for (int tl = 0; tl < nct; ++tl) {
        *(LAS u32x4*)(lds + CMP_K + tl * 8192 + wid * 1024 + lane * 16) = *(const u32x4*)(KC + (size_t)(tl * 64 + lane) * 64 + wid * 8);
        *(LAS u32x4*)(lds + CMP_V + tl * 8192 + wid * 1024 + lane * 16) = *(const u32x4*)(VC + (size_t)(tl * 64 + 16 * (wid & 3) + (lane >> 2)) * 64 + (wid >> 2) * 32 + (lane & 3) * 8);
    }
    LAS unsigned* selL = (LAS unsigned*)(lds + CMP_SEL);
    if (c.tid < 128) selL[c.tid] = 0u;
    const bf16_t* QN = c.w<bf16_t>(WS_QN); bf16_t* OC = c.w<bf16_t>(WS_OCMP);
#pragma unroll 1
    for (int sb = 0; sb < 2; ++sb) {
        const int tb = sb ? 63 - jb : jb;
        if (wid < 6) {
            const int tg = wid / 3, hd = g * 3 + (wid - tg * 3), q0w = tb * 64 + tg * 32, t = q0w + r32;
            const int nw = (q0w / 16) / 64 + 1;
            LAS float* impL = (LAS float*)(lds + CMP_IMP + wid * 8320) + r32 * 65 + hi;
#pragma unroll
            for (int i = 0; i < 32; ++i) impL[2 * i] = 0.f;
            if (sb == 0) __syncthreads();
            const size_t row = (size_t)b * T + t;
            bf16x8 qr[4];
#pragma unroll
            for (int d0 = 0; d0 < 4; ++d0) qr[d0] = *(const bf16x8*)(QN + row * 384 + hd * 64 + d0 * 16 + hi * 8);
            float m = -1e30f, ls = 0.f;
#pragma unroll 1
            for (int tl = 0; tl < nw; ++tl) {
                f32x16 p0, p1; att::qk_tile<64>(p0, p1, lds + CMP_K + tl * 8192, qr, r32, hi);
                cmp_mask(p0, p1, tl * 64 + 4 * hi, t);
                const float mx = att::max32(p0, p1), mn = fmaxf(m, mx);
                float s = 0.f;
#pragma unroll
                for (int r = 0; r < 16; ++r) s += fexp2(p0[r] - mn) + fexp2(p1[r] - mn);
                ls = ls * fexp2(m - mn) + s; m = mn;
            }
            const float lt = ls + __shfl_xor(ls, 32); const float inv = lt > 0.f ? 1.f / lt : 0.f;
            f32x16 o[2]; att::zero_o(o); float prev_y3 = 0.f;
#pragma unroll 1
            for (int tl = 0; tl < nw; ++tl) {
                f32x16 p0, p1; att::qk_tile<64>(p0, p1, lds + CMP_K + tl * 8192, qr, r32, hi);
                cmp_mask(p0, p1, tl * 64 + 4 * hi, t);
#pragma unroll
                for (int r = 0; r < 16; ++r) { p0[r] = fexp2(p0[r] - m) * inv; p1[r] = fexp2(p1[r] - m) * inv; }
                imp_update(impL, p0, 2 * tl, prev_y3, hi); imp_update(impL, p1, 2 * tl + 1, prev_y3, hi);
                att::pv_tile(o, p0, p1, lds + CMP_V + tl * 8192, lane, hi);
            }
            { float ov[2][16];
#pragma unroll
              for (int r = 0; r < 16; ++r) { ov[0][r] = o[0][r]; ov[1][r] = o[1][r]; }
              store_tile_wide(lds + CMP_STG_OFF, wid, ov, OC + ((size_t)b * T + q0w) * 384 + hd * 64, 384, lane); }
        } else if (sb == 0) __syncthreads();
        __syncthreads();
        {
            const int tgk = wid & 1, cq = wid >> 1, t = tb * 64 + tgk * 32 + r32, cur = t >> 6;
            if (tb >= 16) {
                const LAS float* i0 = (const LAS float*)(lds + CMP_IMP + (tgk * 3) * 8320) + r32 * 65;
                unsigned key[64];
#pragma unroll
                for (int j = 0; j < 64; ++j) { const float x = (i0[j] + i0[2080 + j]) + i0[4160 + j];
                    key[j] = (j >= 1 && j <= cur - 2) ? ((__float_as_uint(x) & ~63u) | (unsigned)(63 - j)) : 0u; }
                unsigned own = 0u;
#pragma unroll
                for (int i = 0; i < 8; ++i) {
                    const int mm = cq * 16 + hi * 8 + i;
                    unsigned km = 0u;
#pragma unroll
                    for (int j = 0; j < 64; ++j) km = (j == mm) ? key[j] : km;
                    int cnt = 0;
#pragma unroll
                    for (int j = 0; j < 64; ++j) cnt += (key[j] > km) ? 1 : 0;
                    const bool sel = (mm == 0) || (mm == cur) || (mm == cur - 1) || (km != 0u && cnt < 13);
                    if (sel) own |= 1u << (mm & 31);
                }
                if (own) atomicOr((unsigned*)(selL + (tgk * 32 + r32) * 2 + (cq >> 1)), own);
            }
        }
        __syncthreads();
        if (wid < 2 && lane < 32) {
            const int t = tb * 64 + wid * 32 + lane, cur = t >> 6;
            unsigned long long bits = (2ull << cur) - 1ull;
            if (tb >= 16) bits = ((unsigned long long)selL[(wid * 32 + lane) * 2 + 1] << 32) | selL[(wid * 32 + lane) * 2];
            c.w<unsigned long long>(WS_SEL)[(size_t)bg * T + t] = bits;
            selL[(wid * 32 + lane) * 2] = 0u; selL[(wid * 32 + lane) * 2 + 1] = 0u;
        }
        __syncthreads();
    }
}

__device__ __forceinline__ bf16x8 ldq_scaled(const bf16_t* p, float sc) {
    float f[8]; ld8(p, f); u32x4 w; w.x = cvtpk(f[0] * sc, f[1] * sc); w.y = cvtpk(f[2] * sc, f[3] * sc); w.z = cvtpk(f[4] * sc, f[5] * sc); w.w = cvtpk(f[6] * sc, f[7] * sc); return __builtin_bit_cast(bf16x8, w);
}
__device__ __forceinline__ void mla_unit(const Ctx& c, int b, int h, int qb) {
    const int wid = c.wave, lane = c.lane, r32 = lane & 31, hi = lane >> 5, q0 = qb * 256, q0w = q0 + wid * 32;
    const bf16_t* QKV = c.w<bf16_t>(WS_QKV); const size_t row = (size_t)b * T + q0w + r32; const bf16_t* qrow = QKV + row * 1536;
    bf16x8 qr[6];
    u32x4 qraw[6]; f32x4 tcs[2], tsn[2];
#pragma unroll
    for (int d0 = 0; d0 < 4; ++d0) qraw[d0] = *(const u32x4*)(qrow + h * 64 + d0 * 16 + hi * 8);
    qraw[4] = *(const u32x4*)(qrow + 384 + h * 32 + hi * 8); qraw[5] = *(const u32x4*)(qrow + 384 + h * 32 + 16 + hi * 8);
    { const f32x4* tb4 = (const f32x4*)(c.w<float>(WS_TABA) + row * 32 + hi * 8); tcs[0] = tb4[0]; tcs[1] = tb4[1]; tsn[0] = tb4[4]; tsn[1] = tb4[5]; }
#pragma unroll
    for (int d0 = 0; d0 < 4; ++d0) { float f[8]; up8(qraw[d0], f); u32x4 w; w.x = cvtpk(f[0] * QSC_A, f[1] * QSC_A); w.y = cvtpk(f[2] * QSC_A, f[3] * QSC_A); w.z = cvtpk(f[4] * QSC_A, f[5] * QSC_A); w.w = cvtpk(f[6] * QSC_A, f[7] * QSC_A); qr[d0] = __builtin_bit_cast(bf16x8, w); }
    { float x1[8], x2[8]; up8(qraw[4], x1); up8(qraw[5], x2); float o1[8], o2[8];
      const float tb[8] = {tcs[0].x, tcs[0].y, tcs[0].z, tcs[0].w, tcs[1].x, tcs[1].y, tcs[1].z, tcs[1].w}; const float ts[8] = {tsn[0].x, tsn[0].y, tsn[0].z, tsn[0].w, tsn[1].x, tsn[1].y, tsn[1].z, tsn[1].w};
#pragma unroll
      for (int j = 0; j < 8; ++j) { const float cs = tb[j], sn = ts[j]; o1[j] = (x1[j] * cs - x2[j] * sn) * QSC_A; o2[j] = (x1[j] * sn + x2[j] * cs) * QSC_A; }
      u32x4 w; w.x = cvtpk(o1[0], o1[1]); w.y = cvtpk(o1[2], o1[3]); w.z = cvtpk(o1[4], o1[5]); w.w = cvtpk(o1[6], o1[7]); qr[4] = __builtin_bit_cast(bf16x8, w);
      w.x = cvtpk(o2[0], o2[1]); w.y = cvtpk(o2[2], o2[3]); w.z = cvtpk(o2[4], o2[5]); w.w = cvtpk(o2[6], o2[7]); qr[5] = __builtin_bit_cast(bf16x8, w); }
    const fa::Src6 src{QKV + (size_t)b * T * 1536 + 768 + h * 64, 1536, c.w<bf16_t>(WS_KPE) + (size_t)b * T * 32, 32, QKV + (size_t)b * T * 1536 + 1152 + h * 64, 1536};
    f32x16 o[2];
    fa::unit6<8>(o, qr, src, (q0 + 256) / 64, q0w, c.lds, wid, lane);
    bf16_t* OB = c.w<bf16_t>(WS_OBUF);
    { float ov[2][16];
#pragma unroll
      for (int r = 0; r < 16; ++r) { ov[0][r] = o[0][r]; ov[1][r] = o[1][r]; }
      store_tile_wide(c.lds + ATT_STG_OFF, wid, ov, OB + ((size_t)b * T + q0w) * 1024 + h * 64, 1024, lane); }
}
__device__ __forceinline__ f32x4* o_scratch(const Ctx& c) { int idx = (c.bid * 8 + c.wave) * 512 + c.lane; asm volatile("" : "+v"(idx)); return (f32x4*)c.X + idx; }
__device__ __forceinline__ void o_spill(const Ctx& c, const f32x16 (&o)[2]) { f32x4* p = o_scratch(c);
#pragma unroll
    for (int d0 = 0; d0 < 2; ++d0)
#pragma unroll
        for (int q = 0; q < 4; ++q) p[(d0 * 4 + q) * 64] = (f32x4){o[d0][4 * q], o[d0][4 * q + 1], o[d0][4 * q + 2], o[d0][4 * q + 3]}; }
__device__ __forceinline__ void o_fill(const Ctx& c, f32x16 (&o)[2]) { const f32x4* p = o_scratch(c);
#pragma unroll
    for (int d0 = 0; d0 < 2; ++d0)
#pragma unroll
        for (int q = 0; q < 4; ++q) { const f32x4 v = p[(d0 * 4 + q) * 64]; o[d0][4 * q] = v.x; o[d0][4 * q + 1] = v.y; o[d0][4 * q + 2] = v.z; o[d0][4 * q + 3] = v.w; } }
__device__ __forceinline__ void nsa_unit(const Ctx& c, int b, int hd, int qb) {
    const int wid = c.wave, lane = c.lane, q0 = qb * 256, q0w = q0 + wid * 32, g = hd / 3, bg = b * 2 + g;
    bf16x8 qr[4]; unsigned long long sel;
    { const int r32_ = lane & 31, hi_ = lane >> 5; const size_t row = (size_t)b * T + q0w + r32_;
#pragma unroll
      for (int d0 = 0; d0 < 4; ++d0) qr[d0] = *(const bf16x8*)(c.w<bf16_t>(WS_QN) + row * 384 + hd * 64 + d0 * 16 + hi_ * 8);
      sel = c.w<unsigned long long>(WS_SEL)[(size_t)bg * T + q0w + r32_]; }
    const bf16_t* NKV = c.w<bf16_t>(WS_NKV) + (size_t)bg * T * 64;
    f32x16 o[2];
    { const fa::Src src{NKV + 2 * NKV_STRIDE, 64, NKV + 3 * NKV_STRIDE, 64};
      fa::unit<4, 1, 8>(o, qr, src, 0, (q0 + 256) / 64, q0w, sel, c.lds, wid, lane); }
    o_spill(c, o);
    { const fa::Src src{NKV + 4 * NKV_STRIDE, 64, NKV + 5 * NKV_STRIDE, 64};
      const int tlo = q0 / 64 - 8 > 0 ? q0 / 64 - 8 : 0;
      fa::unit<4, 2, 8>(o, qr, src, tlo, (q0 + 256) / 64, q0w, 0ull, c.lds, wid, lane); }
    const float* gates = c.w<float>(WS_GATES); const bf16_t* OC = c.w<bf16_t>(WS_OCMP); bf16_t* OB = c.w<bf16_t>(WS_OBUF);
    f32x16 os[2]; o_fill(c, os);
    int l2 = c.lane; asm volatile("" : "+v"(l2)); const int r32 = l2 & 31, hi = l2 >> 5;
    float gv[16][3]; bf16_t ocv[16][2];
#pragma unroll
    for (int r = 0; r < 16; ++r) { const size_t rr = (size_t)b * T + q0w + att::crow(r, hi);
        gv[r][0] = gates[rr * 18 + hd * 3]; gv[r][1] = gates[rr * 18 + hd * 3 + 1]; gv[r][2] = gates[rr * 18 + hd * 3 + 2];
        ocv[r][0] = OC[rr * 384 + hd * 64 + r32]; ocv[r][1] = OC[rr * 384 + hd * 64 + 32 + r32]; }
    { float ov[2][16];
#pragma unroll
      for (int r = 0; r < 16; ++r)
#pragma unroll
          for (int d0 = 0; d0 < 2; ++d0) ov[d0][r] = gv[r][0] * bf1(ocv[r][d0]) + gv[r][1] * os[d0][r] + gv[r][2] * o[d0][r];
      store_tile_wide(c.lds + ATT_STG_OFF, wid, ov, OB + ((size_t)b * T + q0w) * 1024 + 384 + hd * 64, 1024, l2); }
}
__device__ __forceinline__ void diff_unit(const Ctx& c, int l, int b, int h, int qb) {
    const int wid = c.wave, lane = c.lane, r32 = lane & 31, hi = lane >> 5, q0 = qb * 256, q0w = q0 + wid * 32;
    const size_t row = (size_t)b * T + q0w + r32;
    const bf16_t* DQ = c.w<bf16_t>(WS_DQ); const bf16_t* DKb = c.w<bf16_t>(WS_DK) + (size_t)b * T * 256; const bf16_t* DVb = c.w<bf16_t>(WS_DV) + (size_t)b * T * 256 + h * 64;
    f32x16 o[2];
    { bf16x8 qr[2];
#pragma unroll
      for (int d0 = 0; d0 < 2; ++d0) qr[d0] = *(const bf16x8*)(DQ + row * 256 + h * 64 + d0 * 16 + hi * 8);
      const fa::Src src{DKb + h * 64, 256, DVb, 256};
      fa::unit<2, 0, 8>(o, qr, src, 0, (q0 + 256) / 64, q0w, 0ull, c.lds, wid, lane); }
    o_spill(c, o);
    { bf16x8 qr[2];
#pragma unroll
      for (int d0 = 0; d0 < 2; ++d0) qr[d0] = *(const bf16x8*)(DQ + row * 256 + h * 64 + 32 + d0 * 16 + hi * 8);
      const fa::Src src{DKb + h * 64 + 32, 256, DVb, 256};
      fa::unit<2, 0, 8>(o, qr, src, 0, (q0 + 256) / 64, q0w, 0ull, c.lds, wid, lane); }
    const float lam = c.w<float>(WS_MISC)[512 + l], lam_init = c.w<float>(WS_MISC)[512 + NL + l];
    const float* sn = c.fin(22, 64, l); const float g0 = sn[r32] * (1.f - lam_init), g1 = sn[32 + r32] * (1.f - lam_init);
    bf16_t* OB = c.w<bf16_t>(WS_OBUF);
    f32x16 o1[2]; o_fill(c, o1);
    float ov[2][16];
#pragma unroll
    for (int r = 0; r < 16; ++r) {
        const float a0 = o1[0][r] - lam * o[0][r], a1 = o1[1][r] - lam * o[1][r];
        float ss = a0 * a0 + a1 * a1;
#pragma unroll
        for (int sft = 1; sft < 32; sft <<= 1) ss += __shfl_xor(ss, sft);
        const float rs = rsqrtf(ss * (1.f / 64.f) + EPS);
        ov[0][r] = a0 * rs * g0; ov[1][r] = a1 * rs * g1;
    }
    store_tile_wide(c.lds + ATT_STG_OFF, wid, ov, OB + ((size_t)b * T + q0w) * 1024 + 768 + h * 64, 1024, lane);
}
#ifndef ONLY_K
#define KEN(k) 1
#else
#define KEN(k) (ONLY_K == (k))
#endif
__device__ __forceinline__ Ctx make_ctx(const void* const* in, float* X, unsigned char* ws) {
    Ctx c; int t_ = threadIdx.x; asm volatile("" : "+v"(t_)); c.tid = t_; c.lane = t_ & 63; c.wave = __builtin_amdgcn_readfirstlane(t_ >> 6);
    extern __shared__ __attribute__((aligned(16))) unsigned char smem[];
    c.lds = (LAS unsigned char*)smem; c.G = gridDim.x; int b_ = blockIdx.x; asm volatile("" : "+s"(b_)); c.bid = b_;
    { __attribute__((address_space(1))) unsigned char* g_ = (__attribute__((address_space(1))) unsigned char*)ws; asm volatile("" : "+s"(g_)); c.ws = (unsigned char*)g_;
      __attribute__((address_space(1))) float* x_ = (__attribute__((address_space(1))) float*)X; asm volatile("" : "+s"(x_)); c.X = (float*)x_; } c.in = in;
    return c;
}
__device__ __forceinline__ int next_unit(const Ctx& c, int ctr_idx) {
    LAS int* slot = (LAS int*)(c.lds + LDS_BYTES - 64);
    __syncthreads();
    if (c.tid == 0) *slot = (int)atomicAdd(c.w<unsigned>(WS_CTL) + 64 * ctr_idx, 1u);
    __syncthreads();
    return *slot;
}
__device__ __forceinline__ void attn_phase(const Ctx& c, int l, int ph) {
    for (;;) {
        const int u = next_unit(c, ph); if (u >= 1024) break;
        const int qb = 15 - (u >> 6), j = u & 63;
#ifndef FA_ONLY
#define FA_ONLY 7
#endif
        const Ctx cu = make_ctx(c.in, c.X, c.ws);
        if (j < 24) { if (FA_ONLY & 1) mla_unit(cu, j / 6, j % 6, qb); }
        else if (j < 48) { if (FA_ONLY & 2) nsa_unit(cu, (j - 24) / 6, (j - 24) % 6, qb); }
        else { if (FA_ONLY & 4) diff_unit(cu, l, (j - 48) / 4, (j - 48) % 4, qb); }
    }
}
constexpr int CTL_PANEL_WORD0 = 4096;
__device__ __forceinline__ void final_fused(const Ctx& c, const pg8::StaticOrder& S) {
    unsigned* ctl = c.w<unsigned>(WS_CTL);
    asm volatile("s_waitcnt vmcnt(0)" ::: "memory");
    __syncthreads();
    if (c.tid == 0) {
        __builtin_amdgcn_fence(__ATOMIC_RELEASE, "agent"); asm volatile("s_waitcnt vmcnt(0)" ::: "memory");
        pg8::Unit u; for (int i = 0; S.next(i, u); ++i) __hip_atomic_fetch_add(ctl + CTL_PANEL_WORD0 + 64 * u.pm, 1u, __ATOMIC_RELAXED, __HIP_MEMORY_SCOPE_AGENT);
        for (int i = 0; S.next(i, u); ++i) { unsigned sp = 0;
            while (__hip_atomic_load(ctl + CTL_PANEL_WORD0 + 64 * u.pm, __ATOMIC_RELAXED, __HIP_MEMORY_SCOPE_AGENT) < 4u) { __builtin_amdgcn_s_sleep(1); if (++sp > (1u << 22)) break; } }
        __builtin_amdgcn_fence(__ATOMIC_ACQUIRE, "agent"); asm volatile("s_waitcnt vmcnt(0)" ::: "memory");
    }
    __syncthreads();
    const float* part = c.w<float>(WS_PART); const f32x4* gn = (const f32x4*)c.in[28] + c.lane;
    pg8::Unit u;
    f32x4 gg[4];
#pragma unroll
    for (int j = 0; j < 4; ++j) gg[j] = gn[64 * j];
    for (int i = 0; S.next(i, u); ++i)
#pragma unroll
        for (int half = 0; half < 2; ++half) {
            f32x4 v[4][4], pp[4][4];
#pragma unroll
            for (int q = 0; q < 4; ++q) { const int row = u.pm * 256 + u.pn * 64 + c.wave + 8 * (half * 4 + q); const f32x4* xr = (const f32x4*)(c.X + (size_t)row * D) + c.lane; const f32x4* p = (const f32x4*)(part + (size_t)row * 16);
#pragma unroll
                for (int j = 0; j < 4; ++j) { v[q][j] = xr[64 * j]; pp[q][j] = p[j]; } }
#pragma unroll
            for (int q = 0; q < 4; ++q) { const int row = u.pm * 256 + u.pn * 64 + c.wave + 8 * (half * 4 + q); f32x4* xr = (f32x4*)(c.X + (size_t)row * D) + c.lane;
                float sm = 0.f;
#pragma unroll
                for (int j = 0; j < 4; ++j) sm += (pp[q][j].x + pp[q][j].y) + (pp[q][j].z + pp[q][j].w);
                const float rs = rsqrtf(sm * (1.f / 1024.f) + EPS);
#pragma unroll
                for (int j = 0; j < 4; ++j) xr[64 * j] = v[q][j] * rs * gg[j]; }
        }
}
__device__ __forceinline__ void final_phase(const Ctx& c) {
    const int gw = c.bid * 8 + c.wave, NGW = c.G * 8, lane = c.lane; const float* part = c.w<float>(WS_PART); const f32x4* gn = (const f32x4*)c.in[28] + lane;
    for (int row = gw; row < M; row += NGW) {
        const float rs = rstd_from_part(part, row); f32x4* xr = (f32x4*)(c.X + (size_t)row * D) + lane;
#pragma unroll
        for (int j = 0; j < 4; ++j) { const f32x4 v = xr[64 * j], gg = gn[64 * j]; xr[64 * j] = v * rs * gg; }
    }
}

#define XB_TMO      128
#define XB_XCNT(j)  (256  + 64 * (j))
#define XB_XSUB(j)  (1280 + 64 * (j))
#define XB_XGEN(j)  (2304 + 64 * (j))
#define XB_TOP      3328
#define XB_TOPGEN   3392
#define XCD_BAR_WORDS 3456
#define XB_SPIN_CAP (1u << 20)
__device__ __forceinline__ unsigned xb_ld(unsigned* p)              { return __hip_atomic_load(p, __ATOMIC_RELAXED, __HIP_MEMORY_SCOPE_AGENT); }
__device__ __forceinline__ unsigned xb_add(unsigned* p, unsigned v) { return __hip_atomic_fetch_add(p, v, __ATOMIC_RELAXED, __HIP_MEMORY_SCOPE_AGENT); }
__device__ __forceinline__ unsigned xb_xcc_id() { return (unsigned)__builtin_amdgcn_s_getreg((3 << 11) | 20) & 0xFu; }
#define XB_SPIN(cond, bar) do { unsigned _sp = 0; while (cond) { __builtin_amdgcn_s_sleep(1); \
    if ((++_sp & 255u) == 0u) { if (xb_ld(&(bar)[XB_TMO])) break; if (_sp > XB_SPIN_CAP) { atomicAdd(&(bar)[XB_TMO], 1u); break; } } } } while (0)
struct XcdBarrier { unsigned* bar; unsigned x; volatile LAS unsigned* st; };
__device__ __forceinline__ XcdBarrier xcd_barrier_post(unsigned* bar, volatile LAS unsigned* st) {
    XcdBarrier b; b.bar = bar; b.x = xb_xcc_id(); b.st = st;
    if (threadIdx.x == 0) (void)xb_add(&bar[XB_XCNT(b.x)], 1u);
    return b;
}
__device__ __forceinline__ void xcd_barrier_complete(unsigned* bar, unsigned x, unsigned& nloc, unsigned& nx) {
    const unsigned G = gridDim.x * gridDim.y * gridDim.z;
    unsigned sum, cnt, mine, sp = 0u;
    for (;;) {
        sum = 0u; cnt = 0u; mine = 0u;
        unsigned cv[16];
#pragma unroll
        for (unsigned j = 0; j < 16; ++j) cv[j] = xb_ld(&bar[XB_XCNT(j)]);
#pragma unroll
        for (unsigned j = 0; j < 16; ++j) { const unsigned c = cv[j]; sum += c; cnt += (c > 0u) ? 1u : 0u; mine = (j == x) ? c : mine; }
        if (sum == G) break;
        __builtin_amdgcn_s_sleep(1);
        if ((++sp & 255u) == 0u) { if (xb_ld(&bar[XB_TMO])) break; if (sp > XB_SPIN_CAP) { atomicAdd(&bar[XB_TMO], 1u); break; } }
    }
    nloc = mine > 0u ? mine : 1u; nx = cnt > 0u ? cnt : 1u;
}
__device__ __forceinline__ void xcd_barrier(const XcdBarrier& b) {
    asm volatile("s_waitcnt vmcnt(0)" ::: "memory");
    __syncthreads();
    if (threadIdx.x == 0) {
        unsigned* bar = b.bar;
        __builtin_amdgcn_s_waitcnt(0);
        unsigned nloc = b.st[0], nx = b.st[1];
        if (nloc == 0u) { xcd_barrier_complete(bar, b.x, nloc, nx); b.st[0] = nloc; b.st[1] = nx; }
        const unsigned old = xb_add(&bar[XB_XSUB(b.x)], 1u);
        const unsigned gen = old / nloc;
        if (old + 1u == (gen + 1u) * nloc) {
            __builtin_amdgcn_fence(__ATOMIC_RELEASE, "agent");
            asm volatile("s_waitcnt vmcnt(0)" ::: "memory");
            const unsigned og = xb_add(&bar[XB_TOP], 1u);
            const unsigned tg = og / nx;
            if (og + 1u == (tg + 1u) * nx) xb_add(&bar[XB_TOPGEN], 1u);
            else XB_SPIN(xb_ld(&bar[XB_TOPGEN]) == tg, bar);
            __builtin_amdgcn_fence(__ATOMIC_ACQUIRE, "agent");
            xb_add(&bar[XB_XGEN(b.x)], 1u);
            asm volatile("s_waitcnt vmcnt(0)" ::: "memory");
        } else {
            XB_SPIN(xb_ld(&bar[XB_XGEN(b.x)]) == gen, bar);
            __builtin_amdgcn_fence(__ATOMIC_ACQUIRE, "agent");
            asm volatile("s_waitcnt vmcnt(0)" ::: "memory");
        }
    }
    __syncthreads();
}
constexpr size_t CTL_BAR_OFF = 32 * KiB;

constexpr int N_PHASES = 24;
__device__ __forceinline__ bool phase_empty(int ph) { return ph == 1 || ph == 12; }
__device__ __forceinline__ void fill_rstab(const Ctx& c, const pg8::StaticOrder& S) {
    LAS float* tab = (LAS float*)(c.lds + pg8::RSTAB_OFF); const float* part = c.w<float>(WS_PART);
    bool okv[4]; f32x4 pv_[4][4];
#pragma unroll
    for (int q = 0; q < 4; ++q) { const int i = (c.tid >> 8) + 2 * q; pg8::Unit u; u.pm = 0; u.pn = 0; okv[q] = S.next(i, u);
        const f32x4* p = (const f32x4*)(part + (size_t)u.pm * 256 * 16) + (c.tid & 255);
#pragma unroll
        for (int k = 0; k < 4; ++k) pv_[q][k] = p[256 * k]; }
#pragma unroll
    for (int q = 0; q < 4; ++q) { const int i = (c.tid >> 8) + 2 * q;
#pragma unroll
        for (int k = 0; k < 4; ++k) { const f32x4 a = pv_[q][k]; float sm = (a.x + a.y) + (a.z + a.w);
            sm = WS_DPP_ADD(sm, 0xB1); sm = WS_DPP_ADD(sm, 0x4E);
            if (okv[q] && (c.tid & 3) == 0) tab[i * 256 + (((c.tid & 255) + 256 * k) >> 2)] = rsqrtf(sm * (1.f / 1024.f) + EPS); } }
    __syncthreads();
}
__device__ __forceinline__ void run_phase(const void* const* in_, float* X_, unsigned char* ws_, int ph, int rep) {
    const Ctx c = make_ctx(in_, X_, ws_);
    const int l = (ph - 1) / 11, k = (ph - 1) % 11;
    LAS unsigned char* lds = c.lds;
    switch (k) {
    case 1: case 9: if (KEN(1)) { pg8::Gemm g{c.w<bf16_t>(WS_XB), c.w<bf16_t>(k == 1 ? WS_W1A : WS_W2A), D, D, D}; pg8::StaticOrder S; S.init(M, 2 * FF, c.G, c.bid);
                      if (rep == 0 && c.G == 256) { if (k == 1) convert_set(c, l, 2, 128, 128); else if (l + 1 < NL) convert_set(c, l + 1, 0, 128, 128); }
                      fill_rstab(c, S);
                      pg8::EpiSwiglu E{c.w<bf16_t>(WS_HFF), c.w<float>(WS_PART), (const LAS float*)(lds + pg8::RSTAB_OFF)}; pg8::gemm_phase(lds, c.tid, g, S, E); } break;
    case 2: case 10: if (KEN(2)) { pg8::Gemm g{c.w<bf16_t>(WS_HFF), c.w<bf16_t>(k == 2 ? WS_W1D : WS_W2D), FF, FF, FF}; pg8::StaticOrder S; S.init(M, D, c.G, c.bid);
                       const bool fin_ = (l == NL - 1 && k == 10 && rep == 0);
                       pg8::EpiResid E{c.X, c.w<bf16_t>(WS_XB), c.w<float>(WS_PART), rep ? 0.f : 0.5f, fin_ ? (c.G == 256 ? 2 : 1) : 0,
                                       c.w<unsigned>(WS_CTL) + CTL_PANEL_WORD0, (const float*)c.in[28], (LAS float*)(lds + pg8::RSTAB_OFF)}; pg8::gemm_phase(lds, c.tid, g, S, E);
                       if (fin_ && c.G != 256) final_fused(c, S); } break;
    case 3: if (KEN(3)) { pg8::Gemm g{c.w<bf16_t>(WS_XB), c.w<bf16_t>(WS_WIN), D, D, D}; pg8::StaticOrder S; S.init(M, HW, c.G, c.bid);
              if (rep == 0) convert_set(c, l, 1, 64, c.G - 64);
              fill_rstab(c, S);
              pg8::EpiRoute E{c.ws, c.w<float>(WS_PART), (const LAS float*)(lds + pg8::RSTAB_OFF)}; pg8::gemm_phase(lds, c.tid, g, S, E); } break;
    case 4: if (KEN(4)) prep_phase(c); break;
    case 5: if (KEN(5)) { pg8::Gemm g{c.w<bf16_t>(WS_OCMP), c.w<bf16_t>(WS_WMLA), 384, 384, 384}; pg8::StaticOrder S; S.init(M, 1536, c.G, c.bid);
              pg8::EpiScale<1> E{c.w<bf16_t>(WS_QKV), 1536, c.w<float>(WS_RSQ), c.w<float>(WS_RSKV), nullptr}; pg8::gemm_phase(lds, c.tid, g, S, E);
              }
              if (KEN(50)) { __syncthreads();
              for (int u = c.G - 1 - c.bid; u < 128; u += c.G) compress_unit(c, l, u); } break;
    case 6: if (KEN(6)) { for (int u = c.bid; u < 256; u += c.G) cmp_unit(c, u);
              if (rep == 0 && c.G != 256 && l + 1 < NL) { convert_set(c, l + 1, 0, 0, c.G); convert_set(c, l + 1, 2, 0, c.G); } } break;
    case 7: if (KEN(7)) attn_phase(c, l, ph + 32 * rep); break;
    case 8: if (KEN(8)) { pg8::Gemm g{c.w<bf16_t>(WS_OBUF), c.w<bf16_t>(WS_WOUT), D, D, D}; pg8::StaticOrder S; S.init(M, D, c.G, c.bid);
              pg8::EpiResid E{c.X, c.w<bf16_t>(WS_XB), c.w<float>(WS_PART), rep ? 0.f : 1.0f, 0, nullptr, nullptr, nullptr}; pg8::gemm_phase(lds, c.tid, g, S, E); } break;
    }
}
__global__ void __launch_bounds__(512, 2) fwd_kernel(Args a) {
    extern __shared__ __attribute__((aligned(16))) unsigned char smem[];
    cg::grid_group grid = cg::this_grid();
    volatile LAS unsigned* bst = (volatile LAS unsigned*)((LAS unsigned char*)smem + LDS_BYTES - 128);
    if (threadIdx.x < 2) bst[threadIdx.x] = 0u;
    __syncthreads();
    const XcdBarrier bar = xcd_barrier_post((unsigned*)(a.ws + WS_CTL + CTL_BAR_OFF), bst);
    int lo = a.ph_lo, hi = a.ph_hi;
    if (lo < 0) grid.sync();
    if (lo == 0) { { const Ctx c = make_ctx(a.in, a.out, a.ws); prologue(c); } lo = 1; if (lo < hi) xcd_barrier(bar); }
    const bool do_final = false; if (hi > N_PHASES - 1) hi = N_PHASES - 1;
    for (int ph = lo; ph < hi; ++ph) {
        if (phase_empty(ph)) continue;
        int reps = 1;
#ifdef PROBE_REP
        { const int k_ = (ph - 1) % 11, kk_ = (k_ == 9) ? 1 : (k_ == 10) ? 2 : k_; if (kk_ == PROBE_REP) reps = 2; }
#endif
        for (int rep = reps - 1; rep >= 0; --rep) run_phase(a.in, a.out, a.ws, ph, rep);
        if (ph + 1 < hi || do_final) { xcd_barrier(bar);
#ifdef PROBE_BAR
            xcd_barrier(bar);
#endif
        }
    }
    if (do_final) { const Ctx c = make_ctx(a.in, a.out, a.ws); final_phase(c); }
}

extern "C" void kernel_launch(void* const* d_in, const int* in_sizes, int n_in, void* d_out, int out_size, void* d_ws, size_t ws_size, hipStream_t stream) {
    static int grid = 0;
    if (grid == 0) {
        if (n_in != 29 || out_size != M * D || ws_size < WS_END) { fprintf(stderr, "kernel_launch: unexpected shapes (n_in %d, out %d, ws %zu)\n", n_in, out_size, ws_size); grid = -1; return; }
        int dev = 0, cus = 0, per_cu = 0;
        hipGetDevice(&dev); hipDeviceGetAttribute(&cus, hipDeviceAttributeMultiprocessorCount, dev);
        hipFuncSetAttribute((const void*)fwd_kernel, hipFuncAttributeMaxDynamicSharedMemorySize, LDS_BYTES);
        hipOccupancyMaxActiveBlocksPerMultiprocessor(&per_cu, (const void*)fwd_kernel, 512, LDS_BYTES);
        if (per_cu < 1) { fprintf(stderr, "kernel_launch: occupancy query says %d blocks/CU\n", per_cu); per_cu = 1; }
        (void)hipGetLastError();
        grid = cus * per_cu;
        fprintf(stderr, "kernel_launch: grid %d (cus %d x %d)\n", grid, cus, per_cu);
    }
    if (grid < 0) return;
    hipMemsetAsync((char*)d_ws + WS_CTL, 0, CTL_BYTES, stream);
    Args a{};
    for (int i = 0; i < 29; ++i) a.in[i] = d_in[i];
    a.out = (float*)d_out; a.ws = (unsigned char*)d_ws;
#if MK_SPLIT
    for (int ph = 0; ph < N_PHASES; ++ph) {
        if (ph == 1 || ph == 12) continue;
        a.ph_lo = ph; a.ph_hi = ph + 1; void* args[] = {&a};
        hipError_t e = hipLaunchCooperativeKernel((const void*)fwd_kernel, dim3(grid), dim3(512), args, LDS_BYTES, stream);
        if (e != hipSuccess) { fprintf(stderr, "launch failed (phase %d): %s\n", ph, hipGetErrorString(e)); return; }
    }
#else
    a.ph_lo = 0; a.ph_hi = N_PHASES; void* args[] = {&a};
    hipError_t e = hipLaunchCooperativeKernel((const void*)fwd_kernel, dim3(grid), dim3(512), args, LDS_BYTES, stream);
    if (e != hipSuccess) fprintf(stderr, "cooperative launch failed: %s (grid %d)\n", hipGetErrorString(e), grid);
#endif
}
```

```cpp
#include <hip/hip_runtime.h>
#include <hip/hip_cooperative_groups.h>
#include <cstdio>
#include <cstdint>
#include <cmath>
namespace cg = cooperative_groups;

#ifndef MK_SPLIT
#define MK_SPLIT 0
#endif

#define LAS __attribute__((address_space(3)))
typedef unsigned short bf16_t;
typedef short bf16x8 __attribute__((ext_vector_type(8)));
typedef short s16x4 __attribute__((ext_vector_type(4)));
typedef float f32x4 __attribute__((ext_vector_type(4)));
typedef float f32x16 __attribute__((ext_vector_type(16)));
typedef unsigned u32x4 __attribute__((ext_vector_type(4)));
typedef unsigned u32x2 __attribute__((ext_vector_type(2)));
typedef float f32x2_t __attribute__((ext_vector_type(2)));
typedef __bf16 bf16x2_t __attribute__((ext_vector_type(2)));

constexpr int NB = 4, T = 4096, M = NB * T, D = 1024, FF = 2816, HW = 2304, NL = 2;
constexpr float EPS = 1e-6f;
constexpr float LOG2E = 1.4426950408889634f;
constexpr float QSC_A = 0.10206207261596575f * LOG2E;
constexpr float QSC_B = 0.125f * LOG2E;
constexpr float QSC_C = 0.17677669529663687f * LOG2E;

constexpr size_t MiB = 1u << 20, KiB = 1024;
constexpr size_t WS_CTL = 0;
constexpr size_t CTL_BYTES = 64 * KiB;
constexpr size_t WS_PART = 1 * MiB;
constexpr size_t WS_RSQ = WS_PART + 1 * MiB;
constexpr size_t WS_RSKV = WS_RSQ + 64 * KiB;
constexpr size_t WS_GATES = WS_RSKV + 64 * KiB;
constexpr size_t WS_SEL = WS_GATES + 1152 * KiB;
constexpr size_t WS_TABA = WS_SEL + 256 * KiB;
constexpr size_t WS_TABB = WS_TABA + 2 * MiB;
constexpr size_t WS_TABC = WS_TABB + 1 * MiB;
constexpr size_t WS_KCMP = WS_TABC + 512 * KiB;
constexpr size_t WS_VCMP = WS_KCMP + 256 * KiB;
constexpr size_t WS_MISC = WS_VCMP + 256 * KiB;
constexpr size_t WS_W1KT = WS_MISC + 4 * KiB;
constexpr size_t WS_W1VT = WS_W1KT + 256 * KiB;
constexpr size_t WS_W2KT = WS_W1VT + 256 * KiB;
constexpr size_t WS_W2VT = WS_W2KT + 8 * KiB;
constexpr size_t WS_OCMP = 9 * MiB;
static_assert(WS_W2VT + 8 * KiB <= WS_OCMP, "small region");
constexpr size_t WS_W1A = 21 * MiB;
constexpr size_t WS_W1D = WS_W1A + 11 * MiB;
constexpr size_t WS_WIN = WS_W1D + 5632 * KiB;
constexpr size_t WS_WMLA = WS_WIN + 4608 * KiB;
constexpr size_t WS_WOUT = WS_WMLA + 1152 * KiB;
constexpr size_t WS_W2A = WS_WOUT + 2 * MiB;
constexpr size_t WS_W2D = WS_W2A + 11 * MiB;
constexpr size_t WS_XB = 62 * MiB;
static_assert(WS_W2D + 5632 * KiB <= WS_XB, "weights region");
constexpr size_t WS_A = 94 * MiB;
constexpr size_t WS_HFF = WS_A, WS_H = WS_A, WS_QKV = WS_A, WS_OBUF = WS_A + 48 * MiB;
constexpr size_t WS_P = 182 * MiB;
constexpr size_t WS_KPE = WS_P;
constexpr size_t WS_QN = WS_KPE + 1 * MiB;
constexpr size_t WS_NKV = WS_QN + 12 * MiB;
constexpr size_t WS_DQ = WS_NKV + 24 * MiB;
constexpr size_t WS_DK = WS_DQ + 8 * MiB;
constexpr size_t WS_DV = WS_DK + 8 * MiB;
constexpr size_t WS_END = WS_DV + 8 * MiB;
static_assert(WS_END <= 256 * MiB, "d_ws map");

constexpr int LDS_BYTES = 147456;

__device__ __forceinline__ unsigned cvtpk(float lo, float hi) { f32x2_t v = {lo, hi}; bf16x2_t b = __builtin_convertvector(v, bf16x2_t); return __builtin_bit_cast(unsigned, b); }
__device__ __forceinline__ float bflo(unsigned w) { return __uint_as_float(w << 16); }
__device__ __forceinline__ float bfhi(unsigned w) { return __uint_as_float(w & 0xffff0000u); }
__device__ __forceinline__ float bf1(bf16_t h) { return __uint_as_float(((unsigned)h) << 16); }
__device__ __forceinline__ bf16_t f2bf(float f) { return (bf16_t)(cvtpk(f, 0.f) & 0xffffu); }
#define WS_DPP_ADD(v, ctrl) ((v) + __builtin_bit_cast(float, __builtin_amdgcn_update_dpp(0, __builtin_bit_cast(int, (v)), (ctrl), 0xf, 0xf, true)))
__device__ __forceinline__ float wave_sum(float v) {
#pragma unroll
    for (int o = 1; o < 64; o <<= 1) v += __shfl_xor(v, o);
    return v;
}
__device__ __forceinline__ float fexp2(float x) { return __builtin_amdgcn_exp2f(x); }
__device__ __forceinline__ float frcp(float x) { return __builtin_amdgcn_rcpf(x); }
__device__ __forceinline__ float silu_f(float g) { return g * frcp(1.f + fexp2(-g * LOG2E)); }
__device__ __forceinline__ float rstd_from_part(const float* part, int row) {
    const f32x4* p = (const f32x4*)(part + (size_t)row * 16);
    const f32x4 a = p[0], b = p[1], c = p[2], d = p[3];
    const float s = ((a.x + a.y) + (a.z + a.w)) + ((b.x + b.y) + (b.z + b.w)) + ((c.x + c.y) + (c.z + c.w)) + ((d.x + d.y) + (d.z + d.w));
    return rsqrtf(s * (1.f / 1024.f) + EPS);
}

namespace pg8 {
constexpr int BM = 256, BK = 64, HALF = 128, HTB = HALF * BK * 2, STAGE_BYTES = 8 * HTB, NXCD = 8, WGM = 4;
__device__ __forceinline__ int lds_byte(int r, int c) { const int st = (r >> 4) * 2 + (c >> 5), rr = r & 15, cc = c & 31, ob = rr * 64 + cc * 2; return st * 1024 + (ob ^ (((ob >> 9) & 1) << 5)); }
__device__ __forceinline__ void stage_rc(int b, int& R, int& C) { const int st = b / 1024, sb = b % 1024, swz = sb ^ (((sb >> 9) & 1) << 5); R = (st >> 1) * 16 + swz / 64; C = (st & 1) * 32 + (swz % 64) / 2; }
__device__ __forceinline__ int perm32(int rho) { const int n = rho >> 4, i = rho & 15; return 8 * (i >> 2) + 4 * n + (i & 3); }
struct Unit { int pm, pn; };
struct Gemm { const bf16_t* A; const bf16_t* Bt; int lda, ldb, K; };
struct StaticOrder {
    int nM, nN, nwg, G, c;
    __device__ void init(int M_, int N_, int G_, int c_) { nM = M_ / BM; nN = N_ / BM; nwg = nM * nN; G = G_; c = c_; }
    __device__ bool next(int i, Unit& u) const {
        const long L = (long)i * G + c; if (L >= nwg) return false;
        int wgid = (int)L; { const int q = nwg / NXCD, r = nwg % NXCD, xcd = wgid % NXCD, off = wgid / NXCD; wgid = (xcd < r ? xcd * (q + 1) : r * (q + 1) + (xcd - r) * q) + off; }
        const int nig = WGM * nN, gid = wgid / nig, fm = gid * WGM, gsz = (nM - fm) < WGM ? (nM - fm) : WGM;
        u.pm = fm + ((wgid % nig) % gsz); u.pn = (wgid % nig) / gsz; return true;
    }
};

constexpr int RSTAB_OFF = 131072, RSTAB_UNITS = 8;
struct EpiSwiglu {
    bf16_t* H; const float* part; const LAS float* tab;
    __device__ __forceinline__ void operator()(const f32x4 (&acc)[2][2][4][2], const Unit& u, int ui, int wr, int wc, int fr, int fq) const {
        const int row0 = u.pm * BM + wr * 64 + fr; const int hc0 = u.pn * 128 + wc * 32 + 8 * fq;
        float rsv[2][4];
#pragma unroll
        for (int ai = 0; ai < 2; ++ai)
#pragma unroll
            for (int m = 0; m < 4; ++m) rsv[ai][m] = ui < RSTAB_UNITS ? tab[ui * 256 + ai * HALF + wr * 64 + m * 16 + fr] : rstd_from_part(part, row0 + ai * HALF + m * 16);
#pragma unroll
        for (int ai = 0; ai < 2; ++ai)
#pragma unroll
            for (int m = 0; m < 4; ++m) {
                const int row = row0 + ai * HALF + m * 16; const float rs = rsv[ai][m]; const float kk = -rs * LOG2E, rs2 = rs * rs;
                u32x4 w4;
#pragma unroll
                for (int bj = 0; bj < 2; ++bj) {
                    const f32x4 g = acc[ai][bj][m][0], uu = acc[ai][bj][m][1];
                    const f32x4 t = g * kk;
                    f32x4 e = {fexp2(t[0]), fexp2(t[1]), fexp2(t[2]), fexp2(t[3])};
                    e = e + 1.f;
                    const f32x4 r = {frcp(e[0]), frcp(e[1]), frcp(e[2]), frcp(e[3])};
                    const f32x4 h = ((g * uu) * rs2) * r;
                    w4[2 * bj] = cvtpk(h[0], h[1]); w4[2 * bj + 1] = cvtpk(h[2], h[3]);
                }
                *(u32x4*)(H + (size_t)row * FF + hc0) = w4;
            }
    }
};
template <int MODE> struct EpiScale {
    bf16_t* O; int ldc; const float* s0; const float* s1; const LAS float* tab;
    __device__ __forceinline__ void operator()(const f32x4 (&acc)[2][2][4][2], const Unit& u, int ui, int wr, int wc, int fr, int fq) const {
        const int row0 = u.pm * BM + wr * 64 + fr; const int col0 = u.pn * BM + wc * 32 + 8 * fq;
        const float* sp = (MODE == 0 || u.pn < 3) ? s0 : s1;
        float rsv[2][4];
#pragma unroll
        for (int ai = 0; ai < 2; ++ai)
#pragma unroll
            for (int m = 0; m < 4; ++m) { const int row = row0 + ai * HALF + m * 16;
                if (MODE == 0) rsv[ai][m] = ui < RSTAB_UNITS ? tab[ui * 256 + ai * HALF + wr * 64 + m * 16 + fr] : rstd_from_part(sp, row); else rsv[ai][m] = sp[row]; }
#pragma unroll
        for (int ai = 0; ai < 2; ++ai)
#pragma unroll
            for (int m = 0; m < 4; ++m) {
                const int row = row0 + ai * HALF + m * 16;
                const float rs = rsv[ai][m];
                bf16_t* rowp = O + (size_t)row * ldc + col0;
#pragma unroll
                for (int bj = 0; bj < 2; ++bj) {
                    const f32x4 v0 = acc[ai][bj][m][0] * rs, v1 = acc[ai][bj][m][1] * rs;
                    u32x4 w; w.x = cvtpk(v0[0], v0[1]); w.y = cvtpk(v0[2], v0[3]); w.z = cvtpk(v1[0], v1[1]); w.w = cvtpk(v1[2], v1[3]);
                    *(u32x4*)(rowp + bj * HALF) = w;
                }
            }
    }
};
__device__ __forceinline__ void route_chunk(int ch, int b, size_t& off, unsigned& ldb) {
    if (ch < 44) { off = WS_OCMP + ch * 16; ldb = 768; }
    else if (ch < 92) { const int e = ch - 44; if ((e & 7) >= 2) { off = WS_QN + e * 16; ldb = 768; } else { off = WS_H + ch * 16; ldb = HW * 2; } }
    else if (ch < 188) { const int e = ch - 92, buf = e >> 4, g = (e >> 3) & 1, hc = e & 7;
        if ((buf & 1) == 0 && hc < 2) { off = WS_H + ch * 16; ldb = HW * 2; } else { off = WS_NKV + ((size_t)buf * (8 * T * 64) + (size_t)(b + g) * T * 64 + hc * 8) * 2; ldb = 128; } }
    else if (ch < 252) { const int e = ch - 188; if ((e & 3) == 0) { off = WS_H + ch * 16; ldb = HW * 2; } else { off = (e < 32 ? WS_DQ + e * 16 : WS_DK + (e - 32) * 16); ldb = 512; } }
    else if (ch < 284) { off = WS_DV + (ch - 252) * 16; ldb = 512; }
    else { off = WS_H + ch * 16; ldb = HW * 2; }
}
struct EpiRoute {
    unsigned char* ws; const float* part; const LAS float* tab;
    __device__ __forceinline__ void operator()(const f32x4 (&acc)[2][2][4][2], const Unit& u, int ui, int wr, int wc, int fr, int fq) const {
        const int row0 = u.pm * BM + wr * 64 + fr;
        float rsv[2][4];
#pragma unroll
        for (int ai = 0; ai < 2; ++ai)
#pragma unroll
            for (int m = 0; m < 4; ++m) rsv[ai][m] = ui < RSTAB_UNITS ? tab[ui * 256 + ai * HALF + wr * 64 + m * 16 + fr] : rstd_from_part(part, row0 + ai * HALF + m * 16);
        size_t off[2]; unsigned ldb[2];
#pragma unroll
        for (int bj = 0; bj < 2; ++bj) route_chunk(u.pn * 32 + bj * 16 + wc * 4 + fq, u.pm >> 4, off[bj], ldb[bj]);
        const bool dual = (u.pn == 1 && wc == 3);
#pragma unroll
        for (int ai = 0; ai < 2; ++ai)
#pragma unroll
            for (int m = 0; m < 4; ++m) {
                const int row = row0 + ai * HALF + m * 16;
                const float rs = rsv[ai][m];
#pragma unroll
                for (int bj = 0; bj < 2; ++bj) {
                    const f32x4 v0 = acc[ai][bj][m][0] * rs, v1 = acc[ai][bj][m][1] * rs;
                    u32x4 w; w.x = cvtpk(v0[0], v0[1]); w.y = cvtpk(v0[2], v0[3]); w.z = cvtpk(v1[0], v1[1]); w.w = cvtpk(v1[2], v1[3]);
                    *(u32x4*)(ws + off[bj] + (size_t)((unsigned)row * ldb[bj])) = w;
                    if (bj == 0 && dual) *(u32x4*)(ws + WS_OCMP + (size_t)((unsigned)row * 768u) + (44 + fq) * 16) = w;
                }
            }
    }
};
struct EpiResid {
    float* X; bf16_t* XB; float* part; float alpha; int last;
    unsigned* pctr; const float* gn; LAS float* tab;
    __device__ __forceinline__ void operator()(const f32x4 (&acc)[2][2][4][2], const Unit& u, int ui, int wr, int wc, int fr, int fq) const {
        const int row0 = u.pm * BM + wr * 64 + fr; const int col0 = u.pn * BM + wc * 32 + 8 * fq;
#pragma unroll
        for (int ai = 0; ai < 2; ++ai) {
            u32x4 pre[4][2];
#pragma unroll
            for (int m = 0; m < 4; ++m) { const bf16_t* xs = XB + (size_t)(row0 + ai * HALF + m * 16) * D + col0;
#pragma unroll
                for (int bj = 0; bj < 2; ++bj) pre[m][bj] = *(const u32x4*)(xs + bj * HALF); }
#pragma unroll
            for (int m = 0; m < 4; ++m) {
                const int row = row0 + ai * HALF + m * 16; float ss = 0.f;
                float* xr = X + (size_t)row * D + col0; bf16_t* br = XB + (size_t)row * D + col0;
#pragma unroll
                for (int bj = 0; bj < 2; ++bj) {
                    const u32x4 p = pre[m][bj];
                    const f32x4 p0 = {__uint_as_float(p.x << 16), __uint_as_float(p.x & 0xffff0000u), __uint_as_float(p.y << 16), __uint_as_float(p.y & 0xffff0000u)};
                    const f32x4 p1 = {__uint_as_float(p.z << 16), __uint_as_float(p.z & 0xffff0000u), __uint_as_float(p.w << 16), __uint_as_float(p.w & 0xffff0000u)};
                    const f32x4 a0 = p0 + acc[ai][bj][m][0] * alpha, a1 = p1 + acc[ai][bj][m][1] * alpha;
                    if (last == 1) { *(f32x4*)(xr + bj * HALF) = a0; *(f32x4*)(xr + bj * HALF + 4) = a1; }
                    else if (last == 0) { u32x4 w; w.x = cvtpk(a0[0], a0[1]); w.y = cvtpk(a0[2], a0[3]); w.z = cvtpk(a1[0], a1[1]); w.w = cvtpk(a1[2], a1[3]);
                           *(u32x4*)(br + bj * HALF) = w; }
                    ss += (a0[0] * a0[0] + a0[1] * a0[1]) + (a0[2] * a0[2] + a0[3] * a0[3]) + (a1[0] * a1[0] + a1[1] * a1[1]) + (a1[2] * a1[2] + a1[3] * a1[3]);
                }
                ss += __shfl_xor(ss, 16); ss += __shfl_xor(ss, 32);
                if (fq == 0) part[(size_t)row * 16 + u.pn * 4 + wc] = ss;
            }
        }
        if (last == 2) {
            asm volatile("s_waitcnt vmcnt(0)" ::: "memory");
            __syncthreads();
            if (threadIdx.x == 0) {
                __builtin_amdgcn_fence(__ATOMIC_RELEASE, "agent"); asm volatile("s_waitcnt vmcnt(0)" ::: "memory");
                __hip_atomic_fetch_add(pctr + 64 * u.pm, 1u, __ATOMIC_RELAXED, __HIP_MEMORY_SCOPE_AGENT);
                unsigned sp = 0;
                while (__hip_atomic_load(pctr + 64 * u.pm, __ATOMIC_RELAXED, __HIP_MEMORY_SCOPE_AGENT) < 4u) { __builtin_amdgcn_s_sleep(1); if (++sp > (1u << 22)) break; }
                __builtin_amdgcn_fence(__ATOMIC_ACQUIRE, "agent"); asm volatile("s_waitcnt vmcnt(0)" ::: "memory");
            }
            __syncthreads();
            { const int t = threadIdx.x; if (t < 256) tab[t] = rstd_from_part(part, u.pm * BM + t); }
            __syncthreads();
            f32x4 gg[2][2];
#pragma unroll
            for (int bj = 0; bj < 2; ++bj) { gg[bj][0] = *(const f32x4*)(gn + col0 + bj * HALF); gg[bj][1] = *(const f32x4*)(gn + col0 + bj * HALF + 4); }
#pragma unroll
            for (int ai = 0; ai < 2; ++ai) {
                u32x4 pre[4][2];
#pragma unroll
                for (int m = 0; m < 4; ++m) { const bf16_t* xs = XB + (size_t)(row0 + ai * HALF + m * 16) * D + col0;
#pragma unroll
                    for (int bj = 0; bj < 2; ++bj) pre[m][bj] = *(const u32x4*)(xs + bj * HALF); }
#pragma unroll
                for (int m = 0; m < 4; ++m) {
                    const int row = row0 + ai * HALF + m * 16; const float rs = tab[ai * HALF + wr * 64 + m * 16 + fr];
                    float* xr = X + (size_t)row * D + col0;
#pragma unroll
                    for (int bj = 0; bj < 2; ++bj) {
                        const u32x4 p = pre[m][bj];
                        const f32x4 p0 = {__uint_as_float(p.x << 16), __uint_as_float(p.x & 0xffff0000u), __uint_as_float(p.y << 16), __uint_as_float(p.y & 0xffff0000u)};
                        const f32x4 p1 = {__uint_as_float(p.z << 16), __uint_as_float(p.z & 0xffff0000u), __uint_as_float(p.w << 16), __uint_as_float(p.w & 0xffff0000u)};
                        const f32x4 a0 = p0 + acc[ai][bj][m][0] * alpha, a1 = p1 + acc[ai][bj][m][1] * alpha;
                        *(f32x4*)(xr + bj * HALF) = a0 * rs * gg[bj][0]; *(f32x4*)(xr + bj * HALF + 4) = a1 * rs * gg[bj][1];
                    }
                }
            }
        }
    }
};

template <class Epi>
__device__ __forceinline__ void gemm_phase(LAS unsigned char* lds, const int tid, const Gemm g, const StaticOrder& S, const Epi& E) {
    const int wid = __builtin_amdgcn_readfirstlane(tid >> 6), lane = tid & 63, wr = wid >> 2, wc = wid & 3, fr = lane & 15, fq = lane >> 4;
    const int K = g.K, nt = K / BK;
    unsigned voffA[2], voffB[2];
#pragma unroll
    for (int i = 0; i < 2; ++i) { int R, C; stage_rc(tid * 16 + i * 8192, R, C); const int Rb = (R & ~31) + perm32(R & 31);
        voffA[i] = (unsigned)(R * g.lda + C) * 2u; voffB[i] = (unsigned)(Rb * g.ldb + C) * 2u; }
    const size_t kstep = (size_t)(BK * 2);
    const size_t hstepA = (size_t)HALF * g.lda * 2, hstepB = (size_t)HALF * g.ldb * 2;
    const size_t tstepA = 2 * hstepA, tstepB = 2 * hstepB;
    const unsigned ldsw = (unsigned)wid * 1024u;
    const int aoff = lds_byte(wr * 64 + fr, fq * 8), boff = lds_byte(wc * 32 + fr, fq * 8);
#define PG8_SA(b, h) (((b) * 2 + (h)) * HTB)
#define PG8_SB(b, h) ((4 + (b) * 2 + (h)) * HTB)
#define PG8_STAGE(bufoff, gbase, voff) do { _Pragma("unroll") for (int _i = 0; _i < 2; ++_i) \
        __builtin_amdgcn_global_load_lds((const unsigned*)((const char*)(gbase) + (voff)[_i]), (LAS unsigned*)(lds + (bufoff) + ldsw + _i * 8192), 16, 0, 0); } while (0)
#define PG8_LDA(dst, b, h) do { _Pragma("unroll") for (int m = 0; m < 4; ++m) _Pragma("unroll") for (int k = 0; k < 2; ++k) dst[m][k] = *(const LAS bf16x8*)(lds + PG8_SA(b, h) + aoff + m * 2048 + k * 1024); } while (0)
#define PG8_LDB(dst, b, h) do { _Pragma("unroll") for (int n = 0; n < 2; ++n) _Pragma("unroll") for (int k = 0; k < 2; ++k) dst[n][k] = *(const LAS bf16x8*)(lds + PG8_SB(b, h) + boff + n * 2048 + k * 1024); } while (0)
#define PG8_MMA(ai, bj, At, Bt) do { __builtin_amdgcn_s_setprio(1); _Pragma("unroll") for (int m = 0; m < 4; ++m) _Pragma("unroll") for (int n = 0; n < 2; ++n) _Pragma("unroll") for (int k = 0; k < 2; ++k) \
        acc[ai][bj][m][n] = __builtin_amdgcn_mfma_f32_16x16x32_bf16(Bt[n][k], At[m][k], acc[ai][bj][m][n], 0, 0, 0); __builtin_amdgcn_s_setprio(0); } while (0)
#define PG8_WAIT_V(n) asm volatile("s_waitcnt vmcnt(" #n ")" ::: "memory")
#define PG8_WAIT_L(n) asm volatile("s_waitcnt lgkmcnt(" #n ")" ::: "memory")
#define PG8_BAR __builtin_amdgcn_s_barrier()
#define PG8_SCHED __builtin_amdgcn_sched_barrier(0)
    Unit cur, nxt; int ui = 0;
    if (!S.next(0, cur)) return;
    f32x4 acc[2][2][4][2];
#pragma unroll
    for (int a = 0; a < 2; ++a)
#pragma unroll
        for (int b = 0; b < 2; ++b)
#pragma unroll
            for (int m = 0; m < 4; ++m)
#pragma unroll
                for (int n = 0; n < 2; ++n) acc[a][b][m][n] = (f32x4){0.f, 0.f, 0.f, 0.f};
    bf16x8 At[4][2], B0[2][2], B1[2][2];
    const char* cA = (const char*)g.A + (size_t)cur.pm * tstepA; const char* cB = (const char*)g.Bt + (size_t)cur.pn * tstepB;
    PG8_STAGE(PG8_SB(0, 0), cB, voffB); PG8_STAGE(PG8_SB(0, 1), cB + hstepB, voffB); PG8_STAGE(PG8_SA(0, 0), cA, voffA); PG8_STAGE(PG8_SA(0, 1), cA + hstepA, voffA);
    if (wr == 1) PG8_BAR;
    PG8_WAIT_V(2); PG8_BAR;
    PG8_STAGE(PG8_SB(1, 0), cB + kstep, voffB); PG8_STAGE(PG8_SA(1, 0), cA + kstep, voffA); PG8_STAGE(PG8_SB(1, 1), cB + hstepB + kstep, voffB);
    PG8_WAIT_V(6); PG8_BAR;
    for (;;) {
        const bool has_next = S.next(ui + 1, nxt);
        const char* nA = has_next ? (const char*)g.A + (size_t)nxt.pm * tstepA : cA; const char* nB = has_next ? (const char*)g.Bt + (size_t)nxt.pn * tstepB : cB;
#pragma unroll 1
        for (int t = 0; t < nt; t += 2) {
            const bool last = (t == nt - 2);
            const char* a1 = cA + (size_t)(t + 1) * kstep;
            const char* a2 = last ? nA : cA + (size_t)(t + 2) * kstep; const char* b2 = last ? nB : cB + (size_t)(t + 2) * kstep;
            const char* a3 = a2 + kstep; const char* b3 = b2 + kstep;
            PG8_LDB(B0, 0, 0); PG8_LDB(B1, 0, 1); PG8_SCHED; PG8_LDA(At, 0, 0); PG8_STAGE(PG8_SA(1, 1), a1 + hstepA, voffA);
            PG8_WAIT_V(8); PG8_WAIT_L(0); PG8_BAR; PG8_MMA(0, 0, At, B0); PG8_MMA(0, 1, At, B1); PG8_BAR; PG8_SCHED;
            PG8_LDA(At, 0, 1); PG8_STAGE(PG8_SB(0, 0), b2, voffB); PG8_STAGE(PG8_SB(0, 1), b2 + hstepB, voffB); PG8_STAGE(PG8_SA(0, 0), a2, voffA);
            PG8_WAIT_V(8); PG8_WAIT_L(0); PG8_BAR; PG8_MMA(1, 0, At, B0); PG8_MMA(1, 1, At, B1); PG8_BAR; PG8_SCHED;
            PG8_LDB(B0, 1, 0); PG8_LDB(B1, 1, 1); PG8_SCHED; PG8_LDA(At, 1, 0); PG8_STAGE(PG8_SA(0, 1), a2 + hstepA, voffA);
            PG8_WAIT_V(8); PG8_WAIT_L(0); PG8_BAR; PG8_MMA(0, 0, At, B0); PG8_MMA(0, 1, At, B1); PG8_BAR; PG8_SCHED;
            PG8_LDA(At, 1, 1); PG8_STAGE(PG8_SB(1, 0), b3, voffB); PG8_STAGE(PG8_SB(1, 1), b3 + hstepB, voffB); PG8_STAGE(PG8_SA(1, 0), a3, voffA);
            PG8_WAIT_V(8); PG8_WAIT_L(0); PG8_BAR; PG8_MMA(1, 0, At, B0); PG8_MMA(1, 1, At, B1); PG8_BAR; PG8_SCHED;
        }
        if (wr == 0) PG8_BAR;
        E(acc, cur, ui, wr, wc, fr, fq);
        if (!has_next) break;
#pragma unroll
        for (int a = 0; a < 2; ++a)
#pragma unroll
            for (int b = 0; b < 2; ++b)
#pragma unroll
                for (int m = 0; m < 4; ++m)
#pragma unroll
                    for (int n = 0; n < 2; ++n) acc[a][b][m][n] = (f32x4){0.f, 0.f, 0.f, 0.f};
        cur = nxt; cA = nA; cB = nB; ++ui;
        if (wr == 1) PG8_BAR;
    }
    PG8_WAIT_V(0);
    PG8_BAR;
#undef PG8_SA
#undef PG8_SB
#undef PG8_STAGE
#undef PG8_LDA
#undef PG8_LDB
#undef PG8_MMA
#undef PG8_WAIT_V
#undef PG8_WAIT_L
#undef PG8_BAR
#undef PG8_SCHED
}
}

namespace att {
constexpr int KOFF = 0, VOFF = 12288, WSOFF = 20480;
__device__ __forceinline__ int crow(int r, int hi) { return (r & 3) + 8 * (r >> 2) + 4 * hi; }
__device__ __forceinline__ s16x4 vtr(const LAS unsigned char* p) { return __builtin_bit_cast(s16x4, __builtin_amdgcn_ds_read_tr16_b64_v4i16((LAS s16x4*)p)); }

struct Stage { u32x4 k0, k1, v; };
struct KV { const bf16_t* K; int kp; const bf16_t* K2; int kp2; const bf16_t* V; int vp; };

template <int DK> __device__ __forceinline__ void stage_load(Stage& s, const KV& kv, int kv0, int wid, int lane) {
    if (DK >= 64 || wid < DK / 8) s.k0 = *(const u32x4*)(kv.K + (size_t)(kv0 + lane) * kv.kp + wid * 8);
    if (DK == 96 && wid < 4) s.k1 = *(const u32x4*)(kv.K2 + (size_t)(kv0 + lane) * kv.kp2 + wid * 8);
    s.v = *(const u32x4*)(kv.V + (size_t)(kv0 + 16 * (wid & 3) + (lane >> 2)) * kv.vp + (wid >> 2) * 32 + (lane & 3) * 8);
}
template <int DK> __device__ __forceinline__ void stage_store(const Stage& s, LAS unsigned char* lds, int wid, int lane) {
    if (DK >= 64 || wid < DK / 8) *(LAS u32x4*)(lds + KOFF + wid * 1024 + lane * 16) = s.k0;
    if (DK == 96 && wid < 4) *(LAS u32x4*)(lds + KOFF + (8 + wid) * 1024 + lane * 16) = s.k1;
    *(LAS u32x4*)(lds + VOFF + wid * 1024 + lane * 16) = s.v;
}
template <int DK> __device__ __forceinline__ void qk_tile(f32x16& p0, f32x16& p1, const LAS unsigned char* kl, const bf16x8 (&qr)[DK / 16], int r32, int hi) {
    p0 = (f32x16){0.f, 0.f, 0.f, 0.f, 0.f, 0.f, 0.f, 0.f, 0.f, 0.f, 0.f, 0.f, 0.f, 0.f, 0.f, 0.f}; p1 = p0;
#pragma unroll
    for (int d0 = 0; d0 < DK / 16; ++d0) {
        const bf16x8 b0 = *(const LAS bf16x8*)(kl + (2 * d0 + hi) * 1024 + r32 * 16);
        const bf16x8 b1 = *(const LAS bf16x8*)(kl + (2 * d0 + hi) * 1024 + 512 + r32 * 16);
        p0 = __builtin_amdgcn_mfma_f32_32x32x16_bf16(b0, qr[d0], p0, 0, 0, 0);
        p1 = __builtin_amdgcn_mfma_f32_32x32x16_bf16(b1, qr[d0], p1, 0, 0, 0);
    }
}
__device__ __forceinline__ float max32(const f32x16& p0, const f32x16& p1) {
    float a = fmaxf(p0[0], p1[0]);
#pragma unroll
    for (int r = 1; r < 16; ++r) a = fmaxf(a, fmaxf(p0[r], p1[r]));
    return fmaxf(a, __shfl_xor(a, 32));
}
__device__ __forceinline__ bf16x8 pack8(const f32x16& p, int b) {
    u32x4 w; w.x = cvtpk(p[b], p[b + 1]); w.y = cvtpk(p[b + 2], p[b + 3]); w.z = cvtpk(p[b + 4], p[b + 5]); w.w = cvtpk(p[b + 6], p[b + 7]);
    return __builtin_bit_cast(bf16x8, w);
}
__device__ __forceinline__ void pv_tile(f32x16 (&o)[2], const f32x16& p0, const f32x16& p1, const LAS unsigned char* vl, int lane, int hi) {
    const bf16x8 pa0 = pack8(p0, 0), pa1 = pack8(p0, 8), pa2 = pack8(p1, 0), pa3 = pack8(p1, 8);
    const LAS unsigned char* vb = vl + ((lane >> 4) & 1) * 32 + (lane & 3) * 8 + (4 * hi + ((lane & 15) >> 2)) * 64;
#pragma unroll
    for (int d0 = 0; d0 < 2; ++d0) {
#pragma unroll
        for (int ks = 0; ks < 4; ++ks) {
            const s16x4 lo = vtr(vb + d0 * 4096 + ks * 1024), hh = vtr(vb + d0 * 4096 + ks * 1024 + 512);
            const bf16x8 vf = (bf16x8){lo[0], lo[1], lo[2], lo[3], hh[0], hh[1], hh[2], hh[3]};
            const bf16x8 pa = ks == 0 ? pa0 : ks == 1 ? pa1 : ks == 2 ? pa2 : pa3;
            o[d0] = __builtin_amdgcn_mfma_f32_32x32x16_bf16(pa, vf, o[d0], 0, 0, 0);
        }
    }
}
template <int MODE> __device__ __forceinline__ void mask_tile(f32x16& p0, f32x16& p1, int kvb, int qpos, bool rowoff) {
    const float NEG = -INFINITY;
#pragma unroll
    for (int r = 0; r < 16; ++r) {
        const int kv = kvb + (r & 3) + 8 * (r >> 2);
        bool k0 = kv > qpos, k1 = kv + 32 > qpos;
        if (MODE == 2) { k0 = k0 || (qpos - kv >= 512); k1 = k1 || (qpos - kv - 32 >= 512); }
        if (MODE == 1) { k0 = k0 || rowoff; k1 = k1 || rowoff; }
        if (k0) p0[r] = NEG; if (k1) p1[r] = NEG;
    }
}
template <int DK, int MODE>
__device__ __forceinline__ void attn_tiles(f32x16 (&o)[2], float& m_run, float& l_run, const bf16x8 (&qr)[DK / 16], const KV& kv, int t_lo, int t_hi, int q0w, unsigned long long sel,
                                           LAS unsigned char* lds, int wid, int lane) {
    const int r32 = lane & 31, hi = lane >> 5, qpos = q0w + r32;
    LAS float* wsf = (LAS float*)(lds + WSOFF + wid * 256);
    Stage st; stage_load<DK>(st, kv, t_lo * 64, wid, lane);
    for (int t = t_lo; t < t_hi; ++t) {
        stage_store<DK>(st, lds, wid, lane);
        __syncthreads();
        if (t + 1 < t_hi) stage_load<DK>(st, kv, (t + 1) * 64, wid, lane);
        bool need = (t * 64 <= q0w + 31);
        if (MODE == 2) need = need && (t * 64 + 63 >= q0w - 511);
        if (need) {
            f32x16 p0, p1;
            qk_tile<DK>(p0, p1, lds + KOFF, qr, r32, hi);
            const bool full = (t * 64 + 63 <= q0w) && (MODE != 2 || (q0w + 31 - t * 64 < 512)) && (MODE != 1);
            if (!full) mask_tile<MODE>(p0, p1, t * 64 + 4 * hi, qpos, MODE == 1 ? !((sel >> t) & 1ull) : false);
            const float mx = max32(p0, p1);
            const float mn = fmaxf(m_run, mx);
            if (__any(mn > m_run)) {
                const float f = fexp2(m_run - mn);
                l_run *= f; m_run = mn;
                wsf[r32] = f;
#pragma unroll
                for (int r = 0; r < 16; ++r) { const float fr_ = wsf[crow(r, hi)]; o[0][r] *= fr_; o[1][r] *= fr_; }
            }
            float s = 0.f;
#pragma unroll
            for (int r = 0; r < 16; ++r) { p0[r] = fexp2(p0[r] - m_run); p1[r] = fexp2(p1[r] - m_run); s += p0[r] + p1[r]; }
            l_run += s;
            pv_tile(o, p0, p1, lds + VOFF, lane, hi);
        }
        __syncthreads();
    }
}
__device__ __forceinline__ void attn_finish(f32x16 (&o)[2], float l_run, LAS unsigned char* lds, int wid, int lane) {
    const int r32 = lane & 31, hi = lane >> 5;
    LAS float* wsf = (LAS float*)(lds + WSOFF + wid * 256);
    const float lt = l_run + __shfl_xor(l_run, 32);
    wsf[r32] = lt > 0.f ? 1.f / lt : 0.f;
#pragma unroll
    for (int r = 0; r < 16; ++r) { const float f = wsf[crow(r, hi)]; o[0][r] *= f; o[1][r] *= f; }
}
__device__ __forceinline__ void zero_o(f32x16 (&o)[2]) {
    o[0] = (f32x16){0.f, 0.f, 0.f, 0.f, 0.f, 0.f, 0.f, 0.f, 0.f, 0.f, 0.f, 0.f, 0.f, 0.f, 0.f, 0.f}; o[1] = o[0];
}
}

namespace fa {
typedef const LAS char* lds_cptr;
constexpr int SLOTB = 8192, LDS_K = 0, LDS_V = 3 * SLOTB, LDS_WS = 6 * SLOTB;
__device__ __forceinline__ int crow(int r, int hi) { return (r & 3) + 8 * (r >> 2) + 4 * hi; }
__device__ __forceinline__ void glds16(const void* gsrc, unsigned lds_dst) { unsigned keep;
    asm volatile("s_mov_b32 %0, m0\n\ts_mov_b32 m0, %2\n\ts_nop 0\n\tglobal_load_lds_dwordx4 %1, off\n\ts_mov_b32 m0, %0" : "=&s"(keep) : "v"(gsrc), "s"(lds_dst) : "memory"); }
__device__ __forceinline__ float max3f(float a, float b, float c) { float r; asm("v_max3_f32 %0, %1, %2, %3" : "=v"(r) : "v"(a), "v"(b), "v"(c)); return r; }
__device__ __forceinline__ float max2f(float a, float b) { float r; asm("v_max_f32_e32 %0, %1, %2" : "=v"(r) : "v"(a), "v"(b)); return r; }
__device__ __forceinline__ float fadd_s(float a, float b) { float r; asm("v_add_f32_e32 %0, %1, %2" : "=v"(r) : "v"(a), "v"(b)); return r; }
__device__ __forceinline__ float fsub_s(float a, float b) { float r; asm("v_sub_f32_e32 %0, %1, %2" : "=v"(r) : "v"(a), "v"(b)); return r; }
#define FA_SBAR() __builtin_amdgcn_sched_barrier(0)
#define FA_WAIT_BAR(N) asm volatile("s_waitcnt vmcnt(" #N ") lgkmcnt(0)\n\ts_barrier" ::: "memory")
template <int NKS> __device__ __forceinline__ void qkt(f32x16& p0, f32x16& p1, lds_cptr Kslot, const bf16x8* qr, const f32x16& negm, int r32, int hi) {
    lds_cptr kb = Kslot + r32 * 32 + ((hi ^ ((r32 >> 3) & 1)) * 16);
#pragma unroll
    for (int d0 = 0; d0 < NKS; ++d0) {
        const bf16x8 b0 = *(const LAS bf16x8*)(kb + d0 * 2048), b1 = *(const LAS bf16x8*)(kb + d0 * 2048 + 1024);
        if (d0 == 0) { p0 = __builtin_amdgcn_mfma_f32_32x32x16_bf16(b0, qr[0], negm, 0, 0, 0); p1 = __builtin_amdgcn_mfma_f32_32x32x16_bf16(b1, qr[0], negm, 0, 0, 0); }
        else { p0 = __builtin_amdgcn_mfma_f32_32x32x16_bf16(b0, qr[d0], p0, 0, 0, 0); p1 = __builtin_amdgcn_mfma_f32_32x32x16_bf16(b1, qr[d0], p1, 0, 0, 0); }
    }
}
template <int NKS> __device__ __forceinline__ void kloadall(bf16x8* kf, lds_cptr kp) {
#pragma unroll
    for (int j = 0; j < NKS; ++j) { kf[2 * j] = *(const LAS bf16x8*)(kp + j * 2048); kf[2 * j + 1] = *(const LAS bf16x8*)(kp + j * 2048 + 1024); }
}
__device__ __forceinline__ void kload2(bf16x8* kf, lds_cptr kp, int j) { kf[2 * j] = *(const LAS bf16x8*)(kp + j * 2048); kf[2 * j + 1] = *(const LAS bf16x8*)(kp + j * 2048 + 1024); }
__device__ __forceinline__ s16x4 vtr(lds_cptr p) { return __builtin_bit_cast(s16x4, __builtin_amdgcn_ds_read_tr16_b64_v4i16((LAS s16x4*)p)); }
__device__ __forceinline__ float rowmax(const f32x16& p0, const f32x16& p1) {
    float a = max3f(p0[0], p0[1], p1[0]), b = max3f(p0[2], p0[3], p1[1]); a = max3f(a, p1[2], p1[3]);
#pragma unroll
    for (int r = 4; r < 16; r += 4) { a = max3f(a, p0[r], p0[r + 1]); b = max3f(b, p0[r + 2], p0[r + 3]); a = max3f(a, p1[r], p1[r + 1]); b = max3f(b, p1[r + 2], p1[r + 3]); }
    const float m = max2f(a, b);
    auto rr = __builtin_amdgcn_permlane32_swap(__float_as_uint(m), __float_as_uint(m), false, false);
    return max2f(__uint_as_float(rr[0]), __uint_as_float(rr[1]));
}
__device__ __forceinline__ void pv(f32x16* o, lds_cptr vb, bf16x8 pa0, bf16x8 pa1, bf16x8 pa2, bf16x8 pa3) {
#pragma unroll
    for (int d0 = 0; d0 < 2; ++d0) {
        s16x4 lo[4], hh[4];
#pragma unroll
        for (int ks = 0; ks < 4; ++ks) { lo[ks] = vtr(vb + d0 * 4096 + ks * 1024); hh[ks] = vtr(vb + d0 * 4096 + ks * 1024 + 512); }
#define FA_PK(k) (bf16x8){lo[k][0], lo[k][1], lo[k][2], lo[k][3], hh[k][0], hh[k][1], hh[k][2], hh[k][3]}
        o[d0] = __builtin_amdgcn_mfma_f32_32x32x16_bf16(pa0, FA_PK(0), o[d0], 0, 0, 0);
        o[d0] = __builtin_amdgcn_mfma_f32_32x32x16_bf16(pa1, FA_PK(1), o[d0], 0, 0, 0);
        o[d0] = __builtin_amdgcn_mfma_f32_32x32x16_bf16(pa2, FA_PK(2), o[d0], 0, 0, 0);
        o[d0] = __builtin_amdgcn_mfma_f32_32x32x16_bf16(pa3, FA_PK(3), o[d0], 0, 0, 0);
#undef FA_PK
    }
}
template <int MODE> __device__ __forceinline__ void mask(f32x16& p0, f32x16& p1, int lim, bool rowoff) {
    if (MODE == 1) lim = rowoff ? -1 : lim;
    asm volatile("" : "+v"(lim));
#pragma unroll
    for (int r = 0; r < 16; ++r) {
        const int cr = (r & 3) + 8 * (r >> 2);
        bool k0 = lim < cr, k1 = lim < cr + 32;
        if (MODE == 2) { k0 = k0 || (lim >= 512 + cr); k1 = k1 || (lim >= 544 + cr); }
        if (k0) p0[r] = -INFINITY; if (k1) p1[r] = -INFINITY;
    }
}
struct Src { const bf16_t* K; int kp; const bf16_t* V; int vp; };
template <int NKS, int MODE, int THRL>
__device__ __forceinline__ void unit(f32x16 (&o)[2], const bf16x8 (&qr)[NKS], const Src& src, int t_lo, int t_hi, int q0w, unsigned long long sel, LAS unsigned char* shm, int wid, int lane) {
    const int r32 = lane & 31, hi = lane >> 5, qpos = q0w + r32;
    const unsigned lds0 = (unsigned)(uintptr_t)shm;
    LAS float* wsf = (LAS float*)(shm + LDS_WS) + wid * 64;
    const int pk = NKS == 2 ? (wid & 3) : wid;
    const int krow = (pk & 1) * 32 + (lane >> 1), kpc = 2 * (pk >> 1) + ((lane & 1) ^ ((krow >> 3) & 1));
    const bf16_t* ksrc = src.K + (size_t)(t_lo * 64 + krow) * src.kp + kpc * 8;
    const bf16_t* vsrc = src.V + (size_t)(t_lo * 64 + 16 * (wid & 3) + (lane >> 2)) * src.vp + (wid >> 2) * 32 + (lane & 3) * 8;
    const unsigned kdst = lds0 + LDS_K + pk * 1024, vdst = lds0 + LDS_V + wid * 1024;
    const size_t ktile = (size_t)64 * src.kp, vtile = (size_t)64 * src.vp;
#define DMA_K(t, slot) glds16(ksrc + (size_t)(t) * ktile, (unsigned)__builtin_amdgcn_readfirstlane(kdst + (slot)))
#define DMA_V(t, slot) glds16(vsrc + (size_t)(t) * vtile, (unsigned)__builtin_amdgcn_readfirstlane(vdst + (slot)))
    const lds_cptr shm3 = (lds_cptr)shm; const lds_cptr kp0 = shm3 + LDS_K + r32 * 32 + ((hi ^ ((r32 >> 3) & 1)) * 16);
    const lds_cptr vp0 = shm3 + LDS_V + ((lane >> 4) & 1) * 32 + (lane & 3) * 8 + (4 * hi + ((lane & 15) >> 2)) * 64;
    bf16x8 kf[8];
    const int NT = t_hi - t_lo;
    DMA_K(0, 0); DMA_V(0, 0); DMA_K(1, SLOTB);
    float mhat = 0.f, l_reg = 0.f; o[0] = f32x16{}; o[1] = f32x16{}; f32x16 negm = f32x16{}; asm volatile("" : "+v"(negm));
#define CMASK(P0, P1, t) do { \
    if (MODE == 0) { if ((t) >= NT - 4) mask<0>(P0, P1, qpos - 4 * hi - (t_lo + (t)) * 64, false); } \
    else if (MODE == 1) { const bool off_ = !((sel >> (t_lo + (t))) & 1ull); \
        if ((t) >= NT - 4) mask<1>(P0, P1, qpos - 4 * hi - (t_lo + (t)) * 64, off_); \
        else { _Pragma("unroll") for (int r_ = 0; r_ < 16; ++r_) { P0[r_] = off_ ? -INFINITY : P0[r_]; P1[r_] = off_ ? -INFINITY : P1[r_]; } } } \
    else { const int ts_ = (t_lo + (t)) * 64; if (!((ts_ + 63 <= q0w) && (q0w + 31 - ts_ < 512))) mask<2>(P0, P1, qpos - 4 * hi - ts_, false); } } while (0)
    bool resc = false;
#define START(P0, P1) do { const float rm = rowmax(P0, P1); resc = false; \
    { const float dl = rm > -1e30f ? rm : 0.f; mhat = fadd_s(mhat, dl); \
      _Pragma("unroll") for (int r = 0; r < 16; ++r) { P0[r] = fsub_s(P0[r], dl); P1[r] = fsub_s(P1[r], dl); } \
      _Pragma("unroll") for (int r = 0; r < 16; ++r) negm[r] = -mhat; asm volatile("" : "+v"(negm)); } \
    _Pragma("unroll") for (int r = 0; r < 16; ++r) P0[r] = __builtin_amdgcn_exp2f(P0[r]); } while (0)
#define RESC() do { if (resc) { asm volatile("s_waitcnt lgkmcnt(0)" ::: "memory"); \
      _Pragma("unroll") for (int d_ = 0; d_ < 2; ++d_) _Pragma("unroll") for (int r = 0; r < 16; ++r) o[d_][r] *= wsf[crow(r, hi)]; } } while (0)
    f32x16 pA0, pA1, pB0, pB1;
    int sl_prev = 0, sl_cur = 0, sl_next = SLOTB;
#define ROT() do { sl_prev = sl_cur; sl_cur = sl_next; sl_next = (sl_next == 2 * SLOTB) ? 0 : sl_next + SLOTB; } while (0)
    DMA_K(2, 2 * SLOTB);
    FA_WAIT_BAR(3);
    qkt<NKS>(pA0, pA1, shm3 + LDS_K, qr, negm, r32, hi); asm volatile("s_nop 15\n\ts_nop 7" : "+v"(pA0), "+v"(pA1)); CMASK(pA0, pA1, 0);
    START(pA0, pA1);
    _Pragma("unroll") for (int r = 0; r < 16; ++r) pA1[r] = __builtin_amdgcn_exp2f(pA1[r]);
    FA_WAIT_BAR(0);
    DMA_K(3, 0); DMA_V(1, SLOTB);
    ROT();
    kloadall<NKS>(kf, kp0 + sl_cur);
    FA_WAIT_BAR(2);
    s16x4 vlo[8], vhi[8]; u32x4 pw0, pw1, pw2, pw3;
#define PKW(P, B) cvtpk(P[B], P[B + 1])
#define PAF(k) __builtin_bit_cast(bf16x8, pw##k)
#define VFR(i) (bf16x8){vlo[i][0], vlo[i][1], vlo[i][2], vlo[i][3], vhi[i][0], vhi[i][1], vhi[i][2], vhi[i][3]}
#define PIN(x) asm volatile("" : "+v"(x))
#define MX3(a, b, c) __builtin_fmaxf(__builtin_fmaxf((a), (b)), (c))
#define GAPA(MF, A0, A1, A2, A3, W0, W1, PW) do { MF; sacc += A0; sacc += A1; sacc += A2; sacc += A3; PIN(sacc); W0; W1; PIN(PW); FA_SBAR(); } while (0)
#define EX(v) __builtin_amdgcn_exp2f(v)
#define GAPB(MF, X, B) do { MF; X[B] = EX(X[B]); X[B + 1] = EX(X[B + 1]); X[B + 2] = EX(X[B + 2]); X[B + 3] = EX(X[B + 3]); PIN(X); FA_SBAR(); } while (0)
#define VRD(i) do { vlo[i] = vtr(vp_ + (((i) >> 2) * 4096 + ((i) & 3) * 1024)); vhi[i] = vtr(vp_ + (((i) >> 2) * 4096 + ((i) & 3) * 1024 + 512)); } while (0)
#define KRD(G, j) do { if ((G) && (j) < NKS) { kload2(kf, kp0 + sl_next, j); FA_SBAR(); } } while (0)
#define QK0(C, kidx, qidx) C = __builtin_amdgcn_mfma_f32_32x32x16_bf16(kf[kidx], qr[qidx], negm, 0, 0, 0)
#define QKN(C, kidx, qidx) do { if (NKS > (qidx)) C = __builtin_amdgcn_mfma_f32_32x32x16_bf16(kf[kidx], qr[(qidx) < NKS ? (qidx) : 0], C, 0, 0, 0); } while (0)
#define STEP(C0, C1, P0, P1, t, GK, GV, GL) do { FA_SBAR(); \
    const lds_cptr vp_ = vp0 + sl_prev; \
    VRD(0); FA_SBAR(); float sacc = (P0[0] + P0[1]); \
    GAPA(QK0(C0, 0, 0),     P0[2], P0[3], P0[4], P0[5],     pw0[0] = PKW(P0, 0), pw0[1] = PKW(P0, 2), pw0); \
    VRD(4); FA_SBAR(); GAPA(QK0(C1, 1, 0),     P0[6], P0[7], P0[8], P0[9],     pw0[2] = PKW(P0, 4), pw0[3] = PKW(P0, 6), pw0); \
    VRD(1); FA_SBAR(); GAPA(QKN(C0, 2, 1),     P0[10], P0[11], P0[12], P0[13], pw1[0] = PKW(P0, 8), pw1[1] = PKW(P0, 10), pw1); \
    VRD(5); FA_SBAR(); GAPA(QKN(C1, 3, 1),     P0[14], P0[15], P1[0], P1[1],   pw1[2] = PKW(P0, 12), pw1[3] = PKW(P0, 14), pw1); \
    VRD(2); FA_SBAR(); GAPA(QKN(C0, 4, 2),     P1[2], P1[3], P1[4], P1[5],     pw2[0] = PKW(P1, 0), pw2[1] = PKW(P1, 2), pw2); \
    VRD(6); FA_SBAR(); GAPA(QKN(C1, 5, 2),     P1[6], P1[7], P1[8], P1[9],     pw2[2] = PKW(P1, 4), pw2[3] = PKW(P1, 6), pw2); \
    VRD(3); FA_SBAR(); GAPA(QKN(C0, 6, 3),     P1[10], P1[11], P1[12], P1[13], pw3[0] = PKW(P1, 8), pw3[1] = PKW(P1, 10), pw3); \
    VRD(7); FA_SBAR(); GAPA(QKN(C1, 7, 3),     P1[14], P1[15], 0.f, 0.f,       pw3[2] = PKW(P1, 12), pw3[3] = PKW(P1, 14), pw3); \
    l_reg += sacc; \
    if (GK) { DMA_K((t) + 3, sl_cur); } if (GV) { DMA_V((t) + 1, sl_next); } \
    CMASK(C0, C1, t); \
    { float a = MX3(C0[0], C0[1], C1[0]), b = MX3(C0[2], C0[3], C1[1]); a = MX3(a, C1[2], C1[3]); \
      _Pragma("unroll") for (int r = 4; r < 16; r += 4) { a = MX3(a, C0[r], C0[r + 1]); b = MX3(b, C0[r + 2], C0[r + 3]); a = MX3(a, C1[r], C1[r + 1]); b = MX3(b, C1[r + 2], C1[r + 3]); } \
      float rm = __builtin_fmaxf(a, b); { auto rr = __builtin_amdgcn_permlane32_swap(__float_as_uint(rm), __float_as_uint(rm), false, false); rm = __builtin_fmaxf(__uint_as_float(rr[0]), __uint_as_float(rr[1])); } \
      resc = false; \
      if (__builtin_expect(__any(rm > (float)THRL), 0)) { const float dl = __builtin_fmaxf(rm, 0.f); mhat += dl; \
        _Pragma("unroll") for (int r = 0; r < 16; ++r) { C0[r] -= dl; C1[r] -= dl; } \
        _Pragma("unroll") for (int r = 0; r < 16; ++r) negm[r] = -mhat; asm volatile("" : "+v"(negm)); \
        const float f = __builtin_amdgcn_exp2f(-dl); l_reg *= f; { int l2_ = lane; asm volatile("" : "+v"(l2_)); if (l2_ < 32) wsf[l2_] = f; } resc = true; } } \
    FA_SBAR(); \
    GAPB(o[0] = __builtin_amdgcn_mfma_f32_32x32x16_bf16(PAF(0), VFR(0), o[0], 0, 0, 0), C0, 0); \
    GAPB(o[1] = __builtin_amdgcn_mfma_f32_32x32x16_bf16(PAF(0), VFR(4), o[1], 0, 0, 0), C0, 4); \
    KRD(GL, 0); GAPB(o[0] = __builtin_amdgcn_mfma_f32_32x32x16_bf16(PAF(1), VFR(1), o[0], 0, 0, 0), C0, 8); \
    KRD(GL, 1); GAPB(o[1] = __builtin_amdgcn_mfma_f32_32x32x16_bf16(PAF(1), VFR(5), o[1], 0, 0, 0), C0, 12); \
    KRD(GL, 2); GAPB(o[0] = __builtin_amdgcn_mfma_f32_32x32x16_bf16(PAF(2), VFR(2), o[0], 0, 0, 0), C1, 0); \
    KRD(GL, 3); GAPB(o[1] = __builtin_amdgcn_mfma_f32_32x32x16_bf16(PAF(2), VFR(6), o[1], 0, 0, 0), C1, 4); \
    GAPB(o[0] = __builtin_amdgcn_mfma_f32_32x32x16_bf16(PAF(3), VFR(3), o[0], 0, 0, 0), C1, 8); \
    GAPB(o[1] = __builtin_amdgcn_mfma_f32_32x32x16_bf16(PAF(3), VFR(7), o[1], 0, 0, 0), C1, 12); \
    } while (0)
    int t = 1;
    for (; t + 5 < NT; t += 2) {
        STEP(pB0, pB1, pA0, pA1, t, true, true, true);       FA_WAIT_BAR(2); RESC(); ROT();
        STEP(pA0, pA1, pB0, pB1, t + 1, true, true, true);   FA_WAIT_BAR(2); RESC(); ROT();
    }
#define ENDW(tt) do { if ((tt) + 3 < NT) { FA_WAIT_BAR(2); } else if ((tt) + 2 < NT) { FA_WAIT_BAR(1); } else { FA_WAIT_BAR(0); } } while (0)
    for (; t + 1 < NT; t += 2) {
        STEP(pB0, pB1, pA0, pA1, t, (t + 3 < NT), (t + 1 < NT), (t + 1 < NT));         ENDW(t);     RESC(); ROT();
        STEP(pA0, pA1, pB0, pB1, t + 1, (t + 4 < NT), (t + 2 < NT), (t + 2 < NT));     ENDW(t + 1); RESC(); ROT();
    }
    STEP(pB0, pB1, pA0, pA1, NT - 1, false, false, false); RESC();
    { float sacc = pB0[0] + pB0[1]; _Pragma("unroll") for (int r = 2; r < 16; ++r) sacc += pB0[r]; _Pragma("unroll") for (int r = 0; r < 16; ++r) sacc += pB1[r]; l_reg += sacc;
      pw0 = (u32x4){PKW(pB0, 0), PKW(pB0, 2), PKW(pB0, 4), PKW(pB0, 6)}; pw1 = (u32x4){PKW(pB0, 8), PKW(pB0, 10), PKW(pB0, 12), PKW(pB0, 14)};
      pw2 = (u32x4){PKW(pB1, 0), PKW(pB1, 2), PKW(pB1, 4), PKW(pB1, 6)}; pw3 = (u32x4){PKW(pB1, 8), PKW(pB1, 10), PKW(pB1, 12), PKW(pB1, 14)};
      FA_SBAR(); pv(o, vp0 + sl_cur, PAF(0), PAF(1), PAF(2), PAF(3)); }
#undef PKW
#undef PAF
#undef VFR
#undef PIN
#undef MX3
#undef GAPA
#undef GAPB
#undef EX
#undef VRD
#undef KRD
#undef QK0
#undef QKN
#undef STEP
#undef ENDW
    { auto rr = __builtin_amdgcn_permlane32_swap(__float_as_uint(l_reg), __float_as_uint(l_reg), false, false); l_reg = __uint_as_float(rr[0]) + __uint_as_float(rr[1]); }
    if (hi == 0) wsf[32 + r32] = l_reg; asm volatile("s_waitcnt lgkmcnt(0)" ::: "memory");
#pragma unroll
    for (int r = 0; r < 16; ++r) { const float rl = __builtin_amdgcn_rcpf(wsf[32 + crow(r, hi)]); o[0][r] *= rl; o[1][r] *= rl; }
    asm volatile("s_waitcnt lgkmcnt(0)\n\ts_barrier" ::: "memory");
#undef DMA_K
#undef DMA_V
#undef CMASK
#undef START
#undef RESC
#undef ROT
}
}

namespace fa {
constexpr int KSL6 = 12288, LDS6_K = 0, LDS6_V = 3 * KSL6, LDS6_WS = LDS6_V + 3 * SLOTB;
struct Src6 { const bf16_t* K; int kp; const bf16_t* K2; int kp2; const bf16_t* V; int vp; };
template <int THRL>
__device__ __forceinline__ void unit6(f32x16 (&o)[2], const bf16x8 (&qr)[6], const Src6& src, int t_hi, int q0w, LAS unsigned char* shm, int wid, int lane) {
    const int r32 = lane & 31, hi = lane >> 5, qpos = q0w + r32;
    const unsigned lds0 = (unsigned)(uintptr_t)shm;
    LAS float* wsf = (LAS float*)(shm + LDS6_WS) + wid * 64;
    const int krow = (wid & 1) * 32 + (lane >> 1), ksw = (lane & 1) ^ ((krow >> 3) & 1);
    const bf16_t* ksrc = src.K + (size_t)krow * src.kp + (2 * (wid >> 1) + ksw) * 8;
    const bf16_t* k2src = src.K2 + (size_t)krow * src.kp2 + (2 * ((wid & 3) >> 1) + ksw) * 8;
    const bf16_t* vsrc = src.V + (size_t)(16 * (wid & 3) + (lane >> 2)) * src.vp + (wid >> 2) * 32 + (lane & 3) * 8;
    const unsigned kdst = lds0 + LDS6_K + wid * 1024, k2dst = lds0 + LDS6_K + (8 + (wid & 3)) * 1024, vdst = lds0 + LDS6_V + wid * 1024;
    const size_t ktile = (size_t)64 * src.kp, k2tile = (size_t)64 * src.kp2, vtile = (size_t)64 * src.vp;
#define DMA_K(t, slot) do { glds16(ksrc + (size_t)(t) * ktile, (unsigned)__builtin_amdgcn_readfirstlane(kdst + (slot))); glds16(k2src + (size_t)(t) * k2tile, (unsigned)__builtin_amdgcn_readfirstlane(k2dst + (slot))); } while (0)
#define DMA_V(t, slot) glds16(vsrc + (size_t)(t) * vtile, (unsigned)__builtin_amdgcn_readfirstlane(vdst + (slot)))
    const lds_cptr shm3 = (lds_cptr)shm; const lds_cptr kp0 = shm3 + LDS6_K + r32 * 32 + ((hi ^ ((r32 >> 3) & 1)) * 16);
    const lds_cptr vp0 = shm3 + LDS6_V + ((lane >> 4) & 1) * 32 + (lane & 3) * 8 + (4 * hi + ((lane & 15) >> 2)) * 64;
    bf16x8 kf[12];
    const int NT = t_hi;
    DMA_K(0, 0); DMA_V(0, 0); DMA_K(1, KSL6);
    float mhat = 0.f, l_reg = 0.f; o[0] = f32x16{}; o[1] = f32x16{}; f32x16 negm = f32x16{}; asm volatile("" : "+v"(negm));
#define CMASK(P0, P1, t) do { if ((t) >= NT - 4) mask<0>(P0, P1, qpos - 4 * hi - (t) * 64, false); } while (0)
    bool resc = false;
#define START(P0, P1) do { const float rm = rowmax(P0, P1); resc = false; \
    { const float dl = rm > -1e30f ? rm : 0.f; mhat = fadd_s(mhat, dl); \
      _Pragma("unroll") for (int r = 0; r < 16; ++r) { P0[r] = fsub_s(P0[r], dl); P1[r] = fsub_s(P1[r], dl); } \
      _Pragma("unroll") for (int r = 0; r < 16; ++r) negm[r] = -mhat; asm volatile("" : "+v"(negm)); } \
    _Pragma("unroll") for (int r = 0; r < 16; ++r) P0[r] = __builtin_amdgcn_exp2f(P0[r]); } while (0)
#define RESC() do { if (resc) { asm volatile("s_waitcnt lgkmcnt(0)" ::: "memory"); \
      _Pragma("unroll") for (int d_ = 0; d_ < 2; ++d_) _Pragma("unroll") for (int r = 0; r < 16; ++r) o[d_][r] *= wsf[crow(r, hi)]; } } while (0)
    f32x16 pA0, pA1, pB0, pB1;
    int kprev = 0, kcur = 0, knext = KSL6, vprev = 0, vcur = 0, vnext = SLOTB;
#define ROT() do { kprev = kcur; kcur = knext; knext = (knext == 2 * KSL6) ? 0 : knext + KSL6; vprev = vcur; vcur = vnext; vnext = (vnext == 2 * SLOTB) ? 0 : vnext + SLOTB; } while (0)
    DMA_K(2, 2 * KSL6);
    FA_WAIT_BAR(5);
    qkt<6>(pA0, pA1, shm3 + LDS6_K, qr, negm, r32, hi); asm volatile("s_nop 15\n\ts_nop 7" : "+v"(pA0), "+v"(pA1)); CMASK(pA0, pA1, 0);
    START(pA0, pA1);
    _Pragma("unroll") for (int r = 0; r < 16; ++r) pA1[r] = __builtin_amdgcn_exp2f(pA1[r]);
    FA_WAIT_BAR(0);
    DMA_K(3, 0); DMA_V(1, SLOTB);
    ROT();
    kloadall<6>(kf, kp0 + kcur);
    FA_WAIT_BAR(3);
    u32x4 pw0, pw1, pw2, pw3;
#define PKW(P, B) cvtpk(P[B], P[B + 1])
#define PAF(k) __builtin_bit_cast(bf16x8, pw##k)
#define PIN(x) asm volatile("" : "+v"(x))
#define MX3(a, b, c) __builtin_fmaxf(__builtin_fmaxf((a), (b)), (c))
#define GAPA(MF, A0, A1, A2, A3, W0, W1, PW) do { MF; sacc += A0; sacc += A1; sacc += A2; sacc += A3; PIN(sacc); W0; W1; PIN(PW); FA_SBAR(); } while (0)
#define EX(v) __builtin_amdgcn_exp2f(v)
#define VLD(i) const s16x4 vl##i = vtr(vp_ + (((i) >> 2) * 4096 + ((i) & 3) * 1024)), vh##i = vtr(vp_ + (((i) >> 2) * 4096 + ((i) & 3) * 1024 + 512))
#define VFR(i) (bf16x8){vl##i[0], vl##i[1], vl##i[2], vl##i[3], vh##i[0], vh##i[1], vh##i[2], vh##i[3]}
#define GAPB(MF, X, B) do { MF; X[B] = EX(X[B]); X[B + 1] = EX(X[B + 1]); X[B + 2] = EX(X[B + 2]); X[B + 3] = EX(X[B + 3]); PIN(X); FA_SBAR(); } while (0)
#define KRD(G, j) do { if (G) { kload2(kf, kp0 + knext, j); FA_SBAR(); } } while (0)
#define QK(C, kidx, qidx) C = __builtin_amdgcn_mfma_f32_32x32x16_bf16(kf[kidx], qr[qidx], C, 0, 0, 0)
#define STEP(C0, C1, P0, P1, t, GK, GV, GL) do { FA_SBAR(); \
    float sacc = (P0[0] + P0[1]); \
    GAPA(C0 = __builtin_amdgcn_mfma_f32_32x32x16_bf16(kf[0], qr[0], negm, 0, 0, 0), P0[2], P0[3], P0[4], P0[5],     pw0[0] = PKW(P0, 0), pw0[1] = PKW(P0, 2), pw0); \
    GAPA(C1 = __builtin_amdgcn_mfma_f32_32x32x16_bf16(kf[1], qr[0], negm, 0, 0, 0), P0[6], P0[7], P0[8], P0[9],     pw0[2] = PKW(P0, 4), pw0[3] = PKW(P0, 6), pw0); \
    GAPA(QK(C0, 2, 1),   P0[10], P0[11], P0[12], P0[13], pw1[0] = PKW(P0, 8), pw1[1] = PKW(P0, 10), pw1); \
    GAPA(QK(C1, 3, 1),   P0[14], P0[15], P1[0], P1[1],   pw1[2] = PKW(P0, 12), pw1[3] = PKW(P0, 14), pw1); \
    GAPA(QK(C0, 4, 2),   P1[2], P1[3], P1[4], P1[5],     pw2[0] = PKW(P1, 0), pw2[1] = PKW(P1, 2), pw2); \
    GAPA(QK(C1, 5, 2),   P1[6], P1[7], P1[8], P1[9],     pw2[2] = PKW(P1, 4), pw2[3] = PKW(P1, 6), pw2); \
    GAPA(QK(C0, 6, 3),   P1[10], P1[11], P1[12], P1[13], pw3[0] = PKW(P1, 8), pw3[1] = PKW(P1, 10), pw3); \
    GAPA(QK(C1, 7, 3),   P1[14], P1[15], 0.f, 0.f,       pw3[2] = PKW(P1, 12), pw3[3] = PKW(P1, 14), pw3); \
    QK(C0, 8, 4); QK(C1, 9, 4); QK(C0, 10, 5); QK(C1, 11, 5); FA_SBAR(); \
    l_reg += sacc; \
    if (GK) { DMA_K((t) + 3, kcur); } if (GV) { DMA_V((t) + 1, vnext); } \
    const lds_cptr vp_ = vp0 + vprev; \
    VLD(0); VLD(4); FA_SBAR(); \
    CMASK(C0, C1, t); \
    { float a = MX3(C0[0], C0[1], C1[0]), b = MX3(C0[2], C0[3], C1[1]); a = MX3(a, C1[2], C1[3]); \
      _Pragma("unroll") for (int r = 4; r < 16; r += 4) { a = MX3(a, C0[r], C0[r + 1]); b = MX3(b, C0[r + 2], C0[r + 3]); a = MX3(a, C1[r], C1[r + 1]); b = MX3(b, C1[r + 2], C1[r + 3]); } \
      float rm = __builtin_fmaxf(a, b); { auto rr = __builtin_amdgcn_permlane32_swap(__float_as_uint(rm), __float_as_uint(rm), false, false); rm = __builtin_fmaxf(__uint_as_float(rr[0]), __uint_as_float(rr[1])); } \
      resc = false; \
      if (__builtin_expect(__any(rm > (float)THRL), 0)) { const float dl = __builtin_fmaxf(rm, 0.f); mhat += dl; \
        _Pragma("unroll") for (int r = 0; r < 16; ++r) { C0[r] -= dl; C1[r] -= dl; } \
        _Pragma("unroll") for (int r = 0; r < 16; ++r) negm[r] = -mhat; asm volatile("" : "+v"(negm)); \
        const float f = __builtin_amdgcn_exp2f(-dl); l_reg *= f; { int l2_ = lane; asm volatile("" : "+v"(l2_)); if (l2_ < 32) wsf[l2_] = f; } resc = true; } } \
    FA_SBAR(); \
    VLD(1); FA_SBAR(); GAPB(o[0] = __builtin_amdgcn_mfma_f32_32x32x16_bf16(PAF(0), VFR(0), o[0], 0, 0, 0), C0, 0); \
    VLD(5); KRD(GL, 0); GAPB(o[1] = __builtin_amdgcn_mfma_f32_32x32x16_bf16(PAF(0), VFR(4), o[1], 0, 0, 0), C0, 4); \
    VLD(2); KRD(GL, 1); GAPB(o[0] = __builtin_amdgcn_mfma_f32_32x32x16_bf16(PAF(1), VFR(1), o[0], 0, 0, 0), C0, 8); \
    VLD(6); KRD(GL, 2); GAPB(o[1] = __builtin_amdgcn_mfma_f32_32x32x16_bf16(PAF(1), VFR(5), o[1], 0, 0, 0), C0, 12); \
    VLD(3); KRD(GL, 3); GAPB(o[0] = __builtin_amdgcn_mfma_f32_32x32x16_bf16(PAF(2), VFR(2), o[0], 0, 0, 0), C1, 0); \
    VLD(7); KRD(GL, 4); GAPB(o[1] = __builtin_amdgcn_mfma_f32_32x32x16_bf16(PAF(2), VFR(6), o[1], 0, 0, 0), C1, 4); \
    KRD(GL, 5); GAPB(o[0] = __builtin_amdgcn_mfma_f32_32x32x16_bf16(PAF(3), VFR(3), o[0], 0, 0, 0), C1, 8); \
    GAPB(o[1] = __builtin_amdgcn_mfma_f32_32x32x16_bf16(PAF(3), VFR(7), o[1], 0, 0, 0), C1, 12); \
    } while (0)
    int t = 1;
    for (; t + 5 < NT; t += 2) {
        STEP(pB0, pB1, pA0, pA1, t, true, true, true);       FA_WAIT_BAR(3); RESC(); ROT();
        STEP(pA0, pA1, pB0, pB1, t + 1, true, true, true);   FA_WAIT_BAR(3); RESC(); ROT();
    }
#define ENDW(tt) do { if ((tt) + 3 < NT) { FA_WAIT_BAR(3); } else if ((tt) + 2 < NT) { FA_WAIT_BAR(1); } else { FA_WAIT_BAR(0); } } while (0)
    for (; t + 1 < NT; t += 2) {
        STEP(pB0, pB1, pA0, pA1, t, (t + 3 < NT), (t + 1 < NT), (t + 1 < NT));         ENDW(t);     RESC(); ROT();
        STEP(pA0, pA1, pB0, pB1, t + 1, (t + 4 < NT), (t + 2 < NT), (t + 2 < NT));     ENDW(t + 1); RESC(); ROT();
    }
    STEP(pB0, pB1, pA0, pA1, NT - 1, false, false, false); RESC();
    { float sacc = pB0[0] + pB0[1]; _Pragma("unroll") for (int r = 2; r < 16; ++r) sacc += pB0[r]; _Pragma("unroll") for (int r = 0; r < 16; ++r) sacc += pB1[r]; l_reg += sacc;
      pw0 = (u32x4){PKW(pB0, 0), PKW(pB0, 2), PKW(pB0, 4), PKW(pB0, 6)}; pw1 = (u32x4){PKW(pB0, 8), PKW(pB0, 10), PKW(pB0, 12), PKW(pB0, 14)};
      pw2 = (u32x4){PKW(pB1, 0), PKW(pB1, 2), PKW(pB1, 4), PKW(pB1, 6)}; pw3 = (u32x4){PKW(pB1, 8), PKW(pB1, 10), PKW(pB1, 12), PKW(pB1, 14)};
      FA_SBAR(); pv(o, vp0 + vcur, PAF(0), PAF(1), PAF(2), PAF(3)); }
#undef PKW
#undef PAF
#undef VFR
#undef VLD
#undef PIN
#undef MX3
#undef GAPA
#undef GAPB
#undef EX
#undef KRD
#undef QK
#undef STEP
#undef ENDW
    { auto rr = __builtin_amdgcn_permlane32_swap(__float_as_uint(l_reg), __float_as_uint(l_reg), false, false); l_reg = __uint_as_float(rr[0]) + __uint_as_float(rr[1]); }
    if (hi == 0) wsf[32 + r32] = l_reg; asm volatile("s_waitcnt lgkmcnt(0)" ::: "memory");
#pragma unroll
    for (int r = 0; r < 16; ++r) { const float rl = __builtin_amdgcn_rcpf(wsf[32 + crow(r, hi)]); o[0][r] *= rl; o[1][r] *= rl; }
    asm volatile("s_waitcnt lgkmcnt(0)\n\ts_barrier" ::: "memory");
#undef DMA_K
#undef DMA_V
#undef CMASK
#undef START
#undef RESC
#undef ROT
}
}

struct Args { const void* in[29]; float* out; unsigned char* ws; int ph_lo, ph_hi; };
struct Ctx {
    LAS unsigned char* lds; int tid, lane, wave, G, bid;
    const void* const* in; float* X; unsigned char* ws;
    __device__ __forceinline__ const float* fin(int i, size_t layer_stride, int l) const { const __attribute__((address_space(1))) float* p = (const __attribute__((address_space(1))) float*)in[i]; asm volatile("" : "+s"(p)); return (const float*)p + layer_stride * (size_t)l; }
    template <class Tp> __device__ __forceinline__ Tp* w(size_t off) const { return (Tp*)(ws + off); }
};
constexpr size_t NKV_STRIDE = (size_t)8 * T * 64;

struct Src { const float* p; int ld, koff, klen; const float* gain; float cs; };
__device__ __forceinline__ Src get_src(const Ctx& c, int l, int mat, int n) {
    Src s; s.p = nullptr; s.ld = 0; s.koff = 0; s.klen = 0; s.gain = nullptr; s.cs = 1.f;
    switch (mat) {
    case 0: { s.p = (((n >> 2) & 1) ? c.fin(4, (size_t)D * FF, l) : c.fin(3, (size_t)D * FF, l)) + ((n >> 8) * 128 + ((n >> 5) & 3) * 32 + ((n >> 3) & 3) * 8 + ((n >> 7) & 1) * 4 + (n & 3)); s.ld = FF; s.klen = D; s.gain = c.fin(2, D, l); } break;
    case 5: { s.p = (((n >> 2) & 1) ? c.fin(26, (size_t)D * FF, l) : c.fin(25, (size_t)D * FF, l)) + ((n >> 8) * 128 + ((n >> 5) & 3) * 32 + ((n >> 3) & 3) * 8 + ((n >> 7) & 1) * 4 + (n & 3)); s.ld = FF; s.klen = D; s.gain = c.fin(24, D, l); } break;
    case 1: { s.p = c.fin(5, (size_t)FF * D, l) + n; s.ld = D; s.klen = FF; } break;
    case 6: { s.p = c.fin(27, (size_t)FF * D, l) + n; s.ld = D; s.klen = FF; } break;
    case 2: { int oc = -1; if (n < 1504) oc = n; else if (n < 2272) oc = n + 18; else if (n < 2290) oc = 1504 + (n - 2272);
              if (oc >= 0) { s.p = c.fin(7, (size_t)D * 2290, l) + oc; s.ld = 2290; s.klen = D; s.gain = c.fin(6, D, l); }
              s.cs = (n >= 352 && n < 736) ? QSC_B : (n >= 1504 && n < 1760) ? QSC_C : 1.f; } break;
    case 3: { if (n < 384) { s.p = c.fin(10, 192 * 576, l) + (n >> 6) * 96 + (n & 63); s.ld = 576; s.klen = 192; s.gain = c.fin(8, 192, l); }
              else if (n < 576) { const int m = n - 384; s.p = c.fin(10, 192 * 576, l) + (m >> 5) * 96 + 64 + (m & 31); s.ld = 576; s.klen = 192; s.gain = c.fin(8, 192, l); }
              else if (n < 768) { }
              else if (n < 1152) { const int m = n - 768; s.p = c.fin(11, 128 * 768, l) + (m >> 6) * 128 + (m & 63); s.ld = 768; s.koff = 192; s.klen = 128; s.gain = c.fin(9, 128, l); }
              else { const int m = n - 1152; s.p = c.fin(11, 128 * 768, l) + (m >> 6) * 128 + 64 + (m & 63); s.ld = 768; s.koff = 192; s.klen = 128; s.gain = c.fin(9, 128, l); } } break;
    case 4: { s.p = c.fin(23, (size_t)D * D, l) + n; s.ld = D; s.klen = D; } break;
    case 7: { s.p = c.fin(14, 2048 * 64, l) + n; s.ld = 64; s.klen = 2048; } break;
    case 8: { s.p = c.fin(16, 2048 * 64, l) + n; s.ld = 64; s.klen = 2048; } break;
    case 9: { s.p = c.fin(15, 64 * 64, l) + n; s.ld = 64; s.klen = 64; } break;
    default: { s.p = c.fin(17, 64 * 64, l) + n; s.ld = 64; s.klen = 64; } break;
    }
    return s;
}
__device__ __forceinline__ void conv_item(const Ctx& c, int l, int mat, int item, LAS float* scr) {
    int N, K; size_t off;
    switch (mat) {
    case 0: N = 5632; K = 1024; off = WS_W1A; break;   case 1: N = 1024; K = 2816; off = WS_W1D; break;
    case 2: N = 2304; K = 1024; off = WS_WIN; break;   case 3: N = 1536; K = 384; off = WS_WMLA; break;
    case 4: N = 1024; K = 1024; off = WS_WOUT; break;  case 5: N = 5632; K = 1024; off = WS_W2A; break;
    case 6: N = 1024; K = 2816; off = WS_W2D; break;   case 7: N = 64; K = 2048; off = WS_W1KT; break;
    case 8: N = 64; K = 2048; off = WS_W1VT; break;    case 9: N = 64; K = 64; off = WS_W2KT; break;
    default: N = 64; K = 64; off = WS_W2VT; break;
    }
    bf16_t* dst = c.w<bf16_t>(off);
    const int lane = c.lane, nblk = N / 32, kb = item / nblk, nb = item % nblk, k0 = 64 * kb, n0 = 32 * nb;
    const Src s = get_src(c, l, mat, n0 + (lane & 31));
    float vv[32], gg[32];
    const bool has = s.p != nullptr, hasg = s.gain != nullptr;
#pragma unroll
    for (int i = 0; i < 32; ++i) {
        const int ks = k0 + 2 * i + (lane >> 5) - s.koff; const bool ok = has && ks >= 0 && ks < s.klen;
        vv[i] = ok ? __builtin_nontemporal_load(s.p + (size_t)ks * s.ld) : 0.f; gg[i] = (ok && hasg) ? s.gain[ks] : 1.f;
    }
#pragma unroll
    for (int i = 0; i < 32; ++i) scr[(2 * i + (lane >> 5)) * 33 + (lane & 31)] = vv[i] * gg[i] * s.cs;
    const int c8 = lane & 7;
#pragma unroll
    for (int j = 0; j < 4; ++j) {
        const int nn = (lane >> 3) + 8 * j; const LAS float* sp = scr + (8 * c8) * 33 + nn;
        u32x4 o; o.x = cvtpk(sp[0 * 33], sp[1 * 33]); o.y = cvtpk(sp[2 * 33], sp[3 * 33]); o.z = cvtpk(sp[4 * 33], sp[5 * 33]); o.w = cvtpk(sp[6 * 33], sp[7 * 33]);
        *(u32x4*)(dst + (size_t)(n0 + nn) * K + k0 + 8 * c8) = o;
    }
}
__device__ __forceinline__ void convert_set(const Ctx& c, int l, int set, int wg0, int nwg) {
    if (c.bid < wg0 || c.bid >= wg0 + nwg) return;
    LAS float* scr = (LAS float*)(c.lds + c.wave * 8448);
    const int gw = (c.bid - wg0) * 8 + c.wave, NGW = nwg * 8;
    if (set == 0) {
        for (int it = gw; it < 2816; it += NGW) conv_item(c, l, 0, it, scr);
    } else if (set == 2) {
        constexpr int total = 1408 + 1152 + 288 + 64 + 64 + 2 + 2;
        for (int it = gw; it < total; it += NGW) {
            int r = it, mat;
            if (r < 1408) mat = 1; else if ((r -= 1408) < 1152) mat = 2; else if ((r -= 1152) < 288) mat = 3;
            else if ((r -= 288) < 64) mat = 7; else if ((r -= 64) < 64) mat = 8; else if ((r -= 64) < 2) mat = 9; else { r -= 2; mat = 10; }
            conv_item(c, l, mat, r, scr);
        }
    } else {
        constexpr int total = 512 + 2816 + 1408;
        for (int it = gw; it < total; it += NGW) {
            int r = it, mat;
            if (r < 512) mat = 4; else if ((r -= 512) < 2816) mat = 5; else { r -= 2816; mat = 6; }
            conv_item(c, l, mat, r, scr);
        }
    }
}

__device__ __forceinline__ void rope_tables(const Ctx& c, int wg0, int nwg) {
    if (c.bid < wg0 || c.bid >= wg0 + nwg) return;
    LAS float* invf = (LAS float*)(c.lds + 72 * 1024);
    if (c.tid < 28) { const int j = c.tid; int jj, half; if (j < 16) { jj = j; half = 16; } else if (j < 24) { jj = j - 16; half = 8; } else { jj = j - 24; half = 4; }
        const float e = (float)(2 * jj) / (float)(2 * half);
        const float pw = (float)pow(500000.0, (double)e); invf[j] = 1.0f / pw; }
    __syncthreads();
    const int* pos = (const int*)c.in[1];
    float* tA = c.w<float>(WS_TABA); float* tB = c.w<float>(WS_TABB); float* tC = c.w<float>(WS_TABC);
    for (int idx = (c.bid - wg0) * 512 + c.tid; idx < M * 28; idx += nwg * 512) {
        const int row = idx / 28, j = idx % 28; const int jj = j < 16 ? j : j < 24 ? j - 16 : j - 24;
        const float ang = (float)pos[row] * invf[j];
        double rev = (double)ang * 0.15915494309189535; rev -= rint(rev);
        const float rf = (float)rev; const float cs = __builtin_amdgcn_cosf(rf), sn = __builtin_amdgcn_sinf(rf);
        if (j < 16) { tA[row * 32 + jj] = cs; tA[row * 32 + 16 + jj] = sn; } else if (j < 24) { tB[row * 16 + jj] = cs; tB[row * 16 + 8 + jj] = sn; } else { tC[row * 8 + jj] = cs; tC[row * 8 + 4 + jj] = sn; }
    }
}
__device__ __forceinline__ void prologue(const Ctx& c) {
    convert_set(c, 0, 0, 0, c.G); if (c.G != 256) convert_set(c, 0, 2, 0, c.G); rope_tables(c, 0, c.G);
    const int gw = c.bid * 8 + c.wave, NGW = c.G * 8, lane = c.lane;
    const float* x = (const float*)c.in[0]; bf16_t* XB = c.w<bf16_t>(WS_XB); float* part = c.w<float>(WS_PART);
    for (int rb = gw; rb < M; rb += 4 * NGW) {
        f32x4 v[4][4];
#pragma unroll
        for (int q = 0; q < 4; ++q) { int row = rb + q * NGW; row = row < M ? row : M - 1; const f32x4* xr = (const f32x4*)(x + (size_t)row * D) + lane;
#pragma unroll
            for (int j = 0; j < 4; ++j) v[q][j] = __builtin_nontemporal_load(xr + 64 * j); }
#pragma unroll
        for (int q = 0; q < 4; ++q) { const int row = rb + q * NGW; if (row >= M) break;
            u32x2* br = (u32x2*)(XB + (size_t)row * D) + lane; float ss = 0.f;
#pragma unroll
            for (int j = 0; j < 4; ++j) { const f32x4 t = v[q][j]; u32x2 w; w.x = cvtpk(t.x, t.y); w.y = cvtpk(t.z, t.w); br[64 * j] = w; ss += (t.x * t.x + t.y * t.y) + (t.z * t.z + t.w * t.w); }
            ss = wave_sum(ss);
            if (lane < 16) part[(size_t)row * 16 + lane] = lane == 0 ? ss : 0.f; }
    }
    float* misc = c.w<float>(WS_MISC);
    for (int o = gw; o < NL * 2 * 64; o += NGW) {
        const int n = o & 63, which = (o >> 6) & 1, l = o >> 7;
        const float* pe = which ? c.fin(13, 2048, l) : c.fin(12, 2048, l); const float* w1 = which ? c.fin(16, 2048 * 64, l) : c.fin(14, 2048 * 64, l);
        float s = 0.f; for (int k = lane; k < 2048; k += 64) s += pe[k] * w1[(size_t)k * 64 + n];
        s = wave_sum(s); if (lane == 0) misc[o] = s;
    }
    if (c.bid == 0 && c.wave < NL) {
        const int l = c.wave; const int i = lane & 31;
        float a = c.fin(18, 32, l)[i] * c.fin(19, 32, l)[i], b = c.fin(20, 32, l)[i] * c.fin(21, 32, l)[i];
        a = wave_sum(a) * 0.5f; b = wave_sum(b) * 0.5f;
        const float lam_init = 0.8f - 0.6f * expf(-0.3f * (float)l);
        if (lane == 0) { misc[512 + l] = expf(a) - expf(b) + lam_init; misc[512 + NL + l] = lam_init; }
    }
}

__device__ __forceinline__ void ld8(const bf16_t* p, float (&f)[8]) { const u32x4 w = *(const u32x4*)p; f[0] = bflo(w.x); f[1] = bfhi(w.x); f[2] = bflo(w.y); f[3] = bfhi(w.y); f[4] = bflo(w.z); f[5] = bfhi(w.z); f[6] = bflo(w.w); f[7] = bfhi(w.w); }
__device__ __forceinline__ void st8(bf16_t* p, const float (&f)[8]) { u32x4 w; w.x = cvtpk(f[0], f[1]); w.y = cvtpk(f[2], f[3]); w.z = cvtpk(f[4], f[5]); w.w = cvtpk(f[6], f[7]); *(u32x4*)p = w; }
__device__ __forceinline__ void up8(const u32x4 w, float (&f)[8]) { f[0] = bflo(w.x); f[1] = bfhi(w.x); f[2] = bflo(w.y); f[3] = bfhi(w.y); f[4] = bflo(w.z); f[5] = bfhi(w.z); f[6] = bflo(w.w); f[7] = bfhi(w.w); }
__device__ __forceinline__ void prep_phase(const Ctx& c) {
    const int gw = c.bid * 8 + c.wave, NGW = c.G * 8, lane = c.lane;
    const bf16_t* H = c.w<bf16_t>(WS_H); const bf16_t* CQ = c.w<bf16_t>(WS_OCMP); bf16_t* KPE = c.w<bf16_t>(WS_KPE); bf16_t* QN = c.w<bf16_t>(WS_QN); bf16_t* NKV = c.w<bf16_t>(WS_NKV);
    bf16_t* DQ = c.w<bf16_t>(WS_DQ); bf16_t* DKb = c.w<bf16_t>(WS_DK); float* gates = c.w<float>(WS_GATES);
    const float* tA = c.w<float>(WS_TABA); const float* tB = c.w<float>(WS_TABB); const float* tC = c.w<float>(WS_TABC);
    float* rsq = c.w<float>(WS_RSQ); float* rskv = c.w<float>(WS_RSKV);
    int role, chA, chB;
    if (lane < 20) { role = 0; chA = 2 * lane; chB = chA + 1; }
    else if (lane < 22) { role = 1; chA = 20 + lane; chB = chA + 2; }
    else if (lane < 28) { role = 2; chA = 44 + 8 * (lane - 22); chB = chA + 1; }
    else if (lane < 34) { role = 3; const int i = lane - 28; chA = 92 + 32 * (i >> 1) + 8 * (i & 1); chB = chA + 1; }
    else if (lane < 50) { role = 4; chA = 188 + 4 * (lane - 34); chB = chA; }
    else if (lane < 53) { role = 5; chA = 284 + (lane - 50); chB = chA; }
    else { role = 6; chA = 284; chB = 284; }
    const bf16_t* sb = role < 2 ? CQ : H; const int sld = role < 2 ? 384 : HW;
    const float* tcp; const float* tsp; int tld;
    if (role == 1) { tcp = tA + (lane == 21 ? 8 : 0); tsp = tcp + 16; tld = 32; }
    else if (role == 2 || role == 3) { tcp = tB; tsp = tB + 8; tld = 16; }
    else { tcp = tC; tsp = tC; tld = 8; }
    for (int rb = gw; rb < M; rb += 4 * NGW) {
        u32x4 hv[4], pv[4]; f32x4 cv[4][2], sv[4][2];
#pragma unroll
        for (int q = 0; q < 4; ++q) { int row = rb + q * NGW; row = row < M ? row : M - 1;
            hv[q] = *(const u32x4*)(sb + (size_t)row * sld + chA * 8); pv[q] = *(const u32x4*)(sb + (size_t)row * sld + chB * 8);
            const f32x4* a = (const f32x4*)(tcp + (size_t)row * tld); const f32x4* b2 = (const f32x4*)(tsp + (size_t)row * tld);
            cv[q][0] = a[0]; cv[q][1] = a[1]; sv[q][0] = b2[0]; sv[q][1] = b2[1]; }
#pragma unroll
        for (int q = 0; q < 4; ++q) {
            const int row = rb + q * NGW; if (row >= M) break;
            const int b = row / T, t = row % T;
            float f[8], g2[8]; up8(hv[q], f); up8(pv[q], g2);
            const float cs[8] = {cv[q][0].x, cv[q][0].y, cv[q][0].z, cv[q][0].w, cv[q][1].x, cv[q][1].y, cv[q][1].z, cv[q][1].w};
            const float sn[8] = {sv[q][0].x, sv[q][0].y, sv[q][0].z, sv[q][0].w, sv[q][1].x, sv[q][1].y, sv[q][1].z, sv[q][1].w};
            float sq = 0.f, skv = 0.f;
            if (role == 0) { float s2 = 0.f;
#pragma unroll
                for (int j = 0; j < 8; ++j) s2 += f[j] * f[j] + g2[j] * g2[j];
                if (lane < 12) sq = s2; else skv = s2; }
            else if (role <= 3) { float o1[8], o2[8];
#pragma unroll
                for (int j = 0; j < 8; ++j) { o1[j] = f[j] * cs[j] - g2[j] * sn[j]; o2[j] = f[j] * sn[j] + g2[j] * cs[j]; }
                bf16_t* d1; bf16_t* d2;
                if (role == 1) { d1 = KPE + (size_t)row * 32 + (lane - 20) * 8; d2 = d1 + 16; }
                else if (role == 2) { d1 = QN + (size_t)row * 384 + (chA - 44) * 8; d2 = d1 + 8; }
                else { const int i = lane - 28, buf = 2 * (i >> 1), g = i & 1; d1 = NKV + (size_t)buf * NKV_STRIDE + ((size_t)(b * 2 + g) * T + t) * 64; d2 = d1 + 8; }
                st8(d1, o1); st8(d2, o2); }
            else if (role == 4) { const int e = chA - 188; float o1[8];
#pragma unroll
                for (int j = 0; j < 4; ++j) { o1[j] = f[j] * cs[j] - f[j + 4] * cs[4 + j]; o1[j + 4] = f[j] * cs[4 + j] + f[j + 4] * cs[j]; }
                st8((e < 32 ? DQ + (size_t)row * 256 + e * 8 : DKb + (size_t)row * 256 + (e - 32) * 8), o1); }
            else if (role == 5) { const int j0 = (chA - 284) * 8;
#pragma unroll
                for (int j = 0; j < 8; ++j) if (j0 + j < 18) gates[(size_t)row * 18 + j0 + j] = frcp(1.f + fexp2(-f[j] * LOG2E)); }
            sq = wave_sum(sq); skv = wave_sum(skv);
            if (lane == 0) { rsq[row] = rsqrtf(sq * (1.f / 192.f) + EPS); rskv[row] = rsqrtf(skv * (1.f / 128.f) + EPS); }
        }
    }
}

__device__ __forceinline__ void compress_unit(const Ctx& c, int l, int unit) {
    const int which = unit & 1, ct = (unit >> 1) & 7, bg = unit >> 4;
    const int wid = c.wave, lane = c.lane, r32 = lane & 31, hi = lane >> 5;
    const bf16_t* src = c.w<bf16_t>(WS_NKV) + (size_t)which * NKV_STRIDE + (size_t)bg * T * 64;
    const bf16_t* w1t = c.w<bf16_t>(which ? WS_W1VT : WS_W1KT); const bf16_t* w2t = c.w<bf16_t>(which ? WS_W2VT : WS_W2KT);
    const float* bias = c.w<float>(WS_MISC) + (l * 2 + which) * 64; bf16_t* dst = c.w<bf16_t>(which ? WS_VCMP : WS_KCMP);
    const int c0 = ct * 32; int cc = c0 + r32; if (cc > 254) cc = 254;
    const bf16_t* arow = src + (size_t)cc * 1024 + wid * 256 + hi * 8;
    f32x16 acc[2]; att::zero_o(acc);
#pragma unroll
    for (int half = 0; half < 2; ++half) {
        bf16x8 af[8], b0[8], b1[8];
#pragma unroll
        for (int k8 = 0; k8 < 8; ++k8) { const int ks = half * 8 + k8; af[k8] = *(const bf16x8*)(arow + ks * 16);
            b0[k8] = *(const bf16x8*)(w1t + (size_t)r32 * 2048 + wid * 256 + ks * 16 + hi * 8); b1[k8] = *(const bf16x8*)(w1t + (size_t)(32 + r32) * 2048 + wid * 256 + ks * 16 + hi * 8); }
#pragma unroll
        for (int k8 = 0; k8 < 8; ++k8) { acc[0] = __builtin_amdgcn_mfma_f32_32x32x16_bf16(af[k8], b0[k8], acc[0], 0, 0, 0); acc[1] = __builtin_amdgcn_mfma_f32_32x32x16_bf16(af[k8], b1[k8], acc[1], 0, 0, 0); }
    }
    LAS float* red = (LAS float*)c.lds; LAS bf16_t* hid = (LAS bf16_t*)(c.lds + 65536);
#pragma unroll
    for (int jh = 0; jh < 2; ++jh)
#pragma unroll
        for (int r = 0; r < 16; ++r) red[((wid * 2 + jh) * 16 + r) * 64 + lane] = acc[jh][r];
    __syncthreads();
    if (wid < 2) {
        const int jh = wid; const float bj = bias[jh * 32 + r32];
#pragma unroll
        for (int r = 0; r < 16; ++r) { float s = 0.f;
#pragma unroll
            for (int w = 0; w < 8; ++w) s += red[((w * 2 + jh) * 16 + r) * 64 + lane];
            hid[att::crow(r, hi) * 72 + jh * 32 + r32] = f2bf(silu_f(s + bj)); }
    }
    __syncthreads();
    if (wid < 2) {
        const int nh = wid; f32x16 a2 = (f32x16){0.f, 0.f, 0.f, 0.f, 0.f, 0.f, 0.f, 0.f, 0.f, 0.f, 0.f, 0.f, 0.f, 0.f, 0.f, 0.f};
#pragma unroll
        for (int s4 = 0; s4 < 4; ++s4) { const bf16x8 a = *(const LAS bf16x8*)(hid + r32 * 72 + s4 * 16 + hi * 8); const bf16x8 bb = *(const bf16x8*)(w2t + (size_t)(nh * 32 + r32) * 64 + s4 * 16 + hi * 8);
            a2 = __builtin_amdgcn_mfma_f32_32x32x16_bf16(a, bb, a2, 0, 0, 0); }
#pragma unroll
        for (int r = 0; r < 16; ++r) { const int ci = c0 + att::crow(r, hi); dst[((size_t)bg * 256 + ci) * 64 + nh * 32 + r32] = f2bf(ci < 255 ? a2[r] : 0.f); }
    }
    __syncthreads();
}

__device__ __forceinline__ void store_tile_wide(LAS unsigned char* stg_base, int wave_slot, const float (&v)[2][16], bf16_t* dst, int pitch, int lane) {
    const int r32 = lane & 31, hi = lane >> 5;
    LAS bf16_t* stg = (LAS bf16_t*)(stg_base + wave_slot * 4096);
#pragma unroll
    for (int r = 0; r < 16; ++r) { const int orow = att::crow(r, hi); stg[orow * 64 + r32] = f2bf(v[0][r]); stg[orow * 64 + 32 + r32] = f2bf(v[1][r]); }
#pragma unroll
    for (int i = 0; i < 4; ++i) { const int row = i * 8 + (lane >> 3), ch = lane & 7; const u32x4 w = *(const LAS u32x4*)(stg + row * 64 + ch * 8); *(u32x4*)(dst + (size_t)row * pitch + ch * 8) = w; }
}
constexpr int ATT_STG_OFF = 65536;
constexpr int CMP_STG_OFF = 116736;

constexpr int CMP_K = 0, CMP_V = 32768, CMP_IMP = 65536, CMP_SEL = 65536 + 6 * 8320;
__device__ __forceinline__ void cmp_mask(f32x16& p0, f32x16& p1, int cb, int t) {
#pragma unroll
    for (int r = 0; r < 16; ++r) { const int cidx = cb + (r & 3) + 8 * (r >> 2); if (16 * cidx + 31 > t) p0[r] = -INFINITY; if (16 * (cidx + 32) + 31 > t) p1[r] = -INFINITY; }
}
__device__ __forceinline__ void imp_update(LAS float* impL, const f32x16& P, int blk, float& prev_y3, int hi) {
    float y[4];
#pragma unroll
    for (int k = 0; k < 4; ++k) y[k] = __shfl_xor(P[4 * k + 3], 32);
#pragma unroll
    for (int k = 0; k < 4; ++k) {
        const float s4 = (P[4 * k] + P[4 * k + 1]) + (P[4 * k + 2] + P[4 * k + 3]);
        const float ex = hi ? y[k] : (k >= 1 ? y[k - 1] : prev_y3);
        impL[2 * k + 8 * blk] += s4 + ex;
    }
    prev_y3 = y[3];
}
__device__ __forceinline__ void cmp_unit(const Ctx& c, int w) {
    const int bg = w >> 5, jb = w & 31, b = bg >> 1, g = bg & 1;
    const int wid = c.wave, lane = c.lane, r32 = lane & 31, hi = lane >> 5;
    const int nct = ((63 - jb) * 64 + 32) / 1024 + 1;
    const bf16_t* KC = c.w<bf16_t>(WS_KCMP) + (size_t)bg * 256 * 64; const bf16_t* VC = c.w<bf16_t>(WS_VCMP) + (size_t)bg * 256 * 64;
    LAS unsigned char* lds = c.lds;
#pragma unroll 1
    for (int tl = 0; tl < nct; ++tl) {
        *(LAS u32x4*)(lds + CMP_K + tl * 8192 + wid * 1024 + lane * 16) = *(const u32x4*)(KC + (size_t)(tl * 64 + lane) * 64 + wid * 8);
        *(LAS u32x4*)(lds + CMP_V + tl * 8192 + wid * 1024 + lane * 16) = *(const u32x4*)(VC + (size_t)(tl * 64 + 16 * (wid & 3) + (lane >> 2)) * 64 + (wid >> 2) * 32 + (lane & 3) * 8);
    }
    LAS unsigned* selL = (LAS unsigned*)(lds + CMP_SEL);
    if (c.tid < 128) selL[c.tid] = 0u;
    const bf16_t* QN = c.w<bf16_t>(WS_QN); bf16_t* OC = c.w<bf16_t>(WS_OCMP);
#pragma unroll 1
    for (int sb = 0; sb < 2; ++sb) {
        const int tb = sb ? 63 - jb : jb;
        if (wid < 6) {
            const int tg = wid / 3, hd = g * 3 + (wid - tg * 3), q0w = tb * 64 + tg * 32, t = q0w + r32;
            const int nw = (q0w / 16) / 64 + 1;
            LAS float* impL = (LAS float*)(lds + CMP_IMP + wid * 8320) + r32 * 65 + hi;
#pragma unroll
            for (int i = 0; i < 32; ++i) impL[2 * i] = 0.f;
            if (sb == 0) __syncthreads();
            const size_t row = (size_t)b * T + t;
            bf16x8 qr[4];
#pragma unroll
            for (int d0 = 0; d0 < 4; ++d0) qr[d0] = *(const bf16x8*)(QN + row * 384 + hd * 64 + d0 * 16 + hi * 8);
            float m = -1e30f, ls = 0.f;
#pragma unroll 1
            for (int tl = 0; tl < nw; ++tl) {
                f32x16 p0, p1; att::qk_tile<64>(p0, p1, lds + CMP_K + tl * 8192, qr, r32, hi);
                cmp_mask(p0, p1, tl * 64 + 4 * hi, t);
                const float mx = att::max32(p0, p1), mn = fmaxf(m, mx);
                float s = 0.f;
#pragma unroll
                for (int r = 0; r < 16; ++r) s += fexp2(p0[r] - mn) + fexp2(p1[r] - mn);
                ls = ls * fexp2(m - mn) + s; m = mn;
            }
            const float lt = ls + __shfl_xor(ls, 32); const float inv = lt > 0.f ? 1.f / lt : 0.f;
            f32x16 o[2]; att::zero_o(o); float prev_y3 = 0.f;
#pragma unroll 1
            for (int tl = 0; tl < nw; ++tl) {
                f32x16 p0, p1; att::qk_tile<64>(p0, p1, lds + CMP_K + tl * 8192, qr, r32, hi);
                cmp_mask(p0, p1, tl * 64 + 4 * hi, t);
#pragma unroll
                for (int r = 0; r < 16; ++r) { p0[r] = fexp2(p0[r] - m) * inv; p1[r] = fexp2(p1[r] - m) * inv; }
                imp_update(impL, p0, 2 * tl, prev_y3, hi); imp_update(impL, p1, 2 * tl + 1, prev_y3, hi);
                att::pv_tile(o, p0, p1, lds + CMP_V + tl * 8192, lane, hi);
            }
            { float ov[2][16];
#pragma unroll
              for (int r = 0; r < 16; ++r) { ov[0][r] = o[0][r]; ov[1][r] = o[1][r]; }
              store_tile_wide(lds + CMP_STG_OFF, wid, ov, OC + ((size_t)b * T + q0w) * 384 + hd * 64, 384, lane); }
        } else if (sb == 0) __syncthreads();
        __syncthreads();
        {
            const int tgk = wid & 1, cq = wid >> 1, t = tb * 64 + tgk * 32 + r32, cur = t >> 6;
            if (tb >= 16) {
                const LAS float* i0 = (const LAS float*)(lds + CMP_IMP + (tgk * 3) * 8320) + r32 * 65;
                unsigned key[64];
#pragma unroll
                for (int j = 0; j < 64; ++j) { const float x = (i0[j] + i0[2080 + j]) + i0[4160 + j];
                    key[j] = (j >= 1 && j <= cur - 2) ? ((__float_as_uint(x) & ~63u) | (unsigned)(63 - j)) : 0u; }
                unsigned own = 0u;
#pragma unroll
                for (int i = 0; i < 8; ++i) {
                    const int mm = cq * 16 + hi * 8 + i;
                    unsigned km = 0u;
#pragma unroll
                    for (int j = 0; j < 64; ++j) km = (j == mm) ? key[j] : km;
                    int cnt = 0;
#pragma unroll
                    for (int j = 0; j < 64; ++j) cnt += (key[j] > km) ? 1 : 0;
                    const bool sel = (mm == 0) || (mm == cur) || (mm == cur - 1) || (km != 0u && cnt < 13);
                    if (sel) own |= 1u << (mm & 31);
                }
                if (own) atomicOr((unsigned*)(selL + (tgk * 32 + r32) * 2 + (cq >> 1)), own);
            }
        }
        __syncthreads();
        if (wid < 2 && lane < 32) {
            const int t = tb * 64 + wid * 32 + lane, cur = t >> 6;
            unsigned long long bits = (2ull << cur) - 1ull;
            if (tb >= 16) bits = ((unsigned long long)selL[(wid * 32 + lane) * 2 + 1] << 32) | selL[(wid * 32 + lane) * 2];
            c.w<unsigned long long>(WS_SEL)[(size_t)bg * T + t] = bits;
            selL[(wid * 32 + lane) * 2] = 0u; selL[(wid * 32 + lane) * 2 + 1] = 0u;
        }
        __syncthreads();
    }
}

__device__ __forceinline__ bf16x8 ldq_scaled(const bf16_t* p, float sc) {
    float f[8]; ld8(p, f); u32x4 w; w.x = cvtpk(f[0] * sc, f[1] * sc); w.y = cvtpk(f[2] * sc, f[3] * sc); w.z = cvtpk(f[4] * sc, f[5] * sc); w.w = cvtpk(f[6] * sc, f[7] * sc); return __builtin_bit_cast(bf16x8, w);
}
__device__ __forceinline__ void mla_unit(const Ctx& c, int b, int h, int qb) {
    const int wid = c.wave, lane = c.lane, r32 = lane & 31, hi = lane >> 5, q0 = qb * 256, q0w = q0 + wid * 32;
    const bf16_t* QKV = c.w<bf16_t>(WS_QKV); const size_t row = (size_t)b * T + q0w + r32; const bf16_t* qrow = QKV + row * 1536;
    bf16x8 qr[6];
    u32x4 qraw[6]; f32x4 tcs[2], tsn[2];
#pragma unroll
    for (int d0 = 0; d0 < 4; ++d0) qraw[d0] = *(const u32x4*)(qrow + h * 64 + d0 * 16 + hi * 8);
    qraw[4] = *(const u32x4*)(qrow + 384 + h * 32 + hi * 8); qraw[5] = *(const u32x4*)(qrow + 384 + h * 32 + 16 + hi * 8);
    { const f32x4* tb4 = (const f32x4*)(c.w<float>(WS_TABA) + row * 32 + hi * 8); tcs[0] = tb4[0]; tcs[1] = tb4[1]; tsn[0] = tb4[4]; tsn[1] = tb4[5]; }
#pragma unroll
    for (int d0 = 0; d0 < 4; ++d0) { float f[8]; up8(qraw[d0], f); u32x4 w; w.x = cvtpk(f[0] * QSC_A, f[1] * QSC_A); w.y = cvtpk(f[2] * QSC_A, f[3] * QSC_A); w.z = cvtpk(f[4] * QSC_A, f[5] * QSC_A); w.w = cvtpk(f[6] * QSC_A, f[7] * QSC_A); qr[d0] = __builtin_bit_cast(bf16x8, w); }
    { float x1[8], x2[8]; up8(qraw[4], x1); up8(qraw[5], x2); float o1[8], o2[8];
      const float tb[8] = {tcs[0].x, tcs[0].y, tcs[0].z, tcs[0].w, tcs[1].x, tcs[1].y, tcs[1].z, tcs[1].w}; const float ts[8] = {tsn[0].x, tsn[0].y, tsn[0].z, tsn[0].w, tsn[1].x, tsn[1].y, tsn[1].z, tsn[1].w};
#pragma unroll
      for (int j = 0; j < 8; ++j) { const float cs = tb[j], sn = ts[j]; o1[j] = (x1[j] * cs - x2[j] * sn) * QSC_A; o2[j] = (x1[j] * sn + x2[j] * cs) * QSC_A; }
      u32x4 w; w.x = cvtpk(o1[0], o1[1]); w.y = cvtpk(o1[2], o1[3]); w.z = cvtpk(o1[4], o1[5]); w.w = cvtpk(o1[6], o1[7]); qr[4] = __builtin_bit_cast(bf16x8, w);
      w.x = cvtpk(o2[0], o2[1]); w.y = cvtpk(o2[2], o2[3]); w.z = cvtpk(o2[4], o2[5]); w.w = cvtpk(o2[6], o2[7]); qr[5] = __builtin_bit_cast(bf16x8, w); }
    const fa::Src6 src{QKV + (size_t)b * T * 1536 + 768 + h * 64, 1536, c.w<bf16_t>(WS_KPE) + (size_t)b * T * 32, 32, QKV + (size_t)b * T * 1536 + 1152 + h * 64, 1536};
    f32x16 o[2];
    fa::unit6<8>(o, qr, src, (q0 + 256) / 64, q0w, c.lds, wid, lane);
    bf16_t* OB = c.w<bf16_t>(WS_OBUF);
    { float ov[2][16];
#pragma unroll
      for (int r = 0; r < 16; ++r) { ov[0][r] = o[0][r]; ov[1][r] = o[1][r]; }
      store_tile_wide(c.lds + ATT_STG_OFF, wid, ov, OB + ((size_t)b * T + q0w) * 1024 + h * 64, 1024, lane); }
}
__device__ __forceinline__ f32x4* o_scratch(const Ctx& c) { int idx = (c.bid * 8 + c.wave) * 512 + c.lane; asm volatile("" : "+v"(idx)); return (f32x4*)c.X + idx; }
__device__ __forceinline__ void o_spill(const Ctx& c, const f32x16 (&o)[2]) { f32x4* p = o_scratch(c);
#pragma unroll
    for (int d0 = 0; d0 < 2; ++d0)
#pragma unroll
        for (int q = 0; q < 4; ++q) p[(d0 * 4 + q) * 64] = (f32x4){o[d0][4 * q], o[d0][4 * q + 1], o[d0][4 * q + 2], o[d0][4 * q + 3]}; }
__device__ __forceinline__ void o_fill(const Ctx& c, f32x16 (&o)[2]) { const f32x4* p = o_scratch(c);
#pragma unroll
    for (int d0 = 0; d0 < 2; ++d0)
#pragma unroll
        for (int q = 0; q < 4; ++q) { const f32x4 v = p[(d0 * 4 + q) * 64]; o[d0][4 * q] = v.x; o[d0][4 * q + 1] = v.y; o[d0][4 * q + 2] = v.z; o[d0][4 * q + 3] = v.w; } }
__device__ __forceinline__ void nsa_unit(const Ctx& c, int b, int hd, int qb) {
    const int wid = c.wave, lane = c.lane, q0 = qb * 256, q0w = q0 + wid * 32, g = hd / 3, bg = b * 2 + g;
    bf16x8 qr[4]; unsigned long long sel;
    { const int r32_ = lane & 31, hi_ = lane >> 5; const size_t row = (size_t)b * T + q0w + r32_;
#pragma unroll
      for (int d0 = 0; d0 < 4; ++d0) qr[d0] = *(const bf16x8*)(c.w<bf16_t>(WS_QN) + row * 384 + hd * 64 + d0 * 16 + hi_ * 8);
      sel = c.w<unsigned long long>(WS_SEL)[(size_t)bg * T + q0w + r32_]; }
    const bf16_t* NKV = c.w<bf16_t>(WS_NKV) + (size_t)bg * T * 64;
    f32x16 o[2];
    { const fa::Src src{NKV + 2 * NKV_STRIDE, 64, NKV + 3 * NKV_STRIDE, 64};
      fa::unit<4, 1, 8>(o, qr, src, 0, (q0 + 256) / 64, q0w, sel, c.lds, wid, lane); }
    o_spill(c, o);
    { const fa::Src src{NKV + 4 * NKV_STRIDE, 64, NKV + 5 * NKV_STRIDE, 64};
      const int tlo = q0 / 64 - 8 > 0 ? q0 / 64 - 8 : 0;
      fa::unit<4, 2, 8>(o, qr, src, tlo, (q0 + 256) / 64, q0w, 0ull, c.lds, wid, lane); }
    const float* gates = c.w<float>(WS_GATES); const bf16_t* OC = c.w<bf16_t>(WS_OCMP); bf16_t* OB = c.w<bf16_t>(WS_OBUF);
    f32x16 os[2]; o_fill(c, os);
    int l2 = c.lane; asm volatile("" : "+v"(l2)); const int r32 = l2 & 31, hi = l2 >> 5;
    float gv[16][3]; bf16_t ocv[16][2];
#pragma unroll
    for (int r = 0; r < 16; ++r) { const size_t rr = (size_t)b * T + q0w + att::crow(r, hi);
        gv[r][0] = gates[rr * 18 + hd * 3]; gv[r][1] = gates[rr * 18 + hd * 3 + 1]; gv[r][2] = gates[rr * 18 + hd * 3 + 2];
        ocv[r][0] = OC[rr * 384 + hd * 64 + r32]; ocv[r][1] = OC[rr * 384 + hd * 64 + 32 + r32]; }
    { float ov[2][16];
#pragma unroll
      for (int r = 0; r < 16; ++r)
#pragma unroll
          for (int d0 = 0; d0 < 2; ++d0) ov[d0][r] = gv[r][0] * bf1(ocv[r][d0]) + gv[r][1] * os[d0][r] + gv[r][2] * o[d0][r];
      store_tile_wide(c.lds + ATT_STG_OFF, wid, ov, OB + ((size_t)b * T + q0w) * 1024 + 384 + hd * 64, 1024, l2); }
}
__device__ __forceinline__ void diff_unit(const Ctx& c, int l, int b, int h, int qb) {
    const int wid = c.wave, lane = c.lane, r32 = lane & 31, hi = lane >> 5, q0 = qb * 256, q0w = q0 + wid * 32;
    const size_t row = (size_t)b * T + q0w + r32;
    const bf16_t* DQ = c.w<bf16_t>(WS_DQ); const bf16_t* DKb = c.w<bf16_t>(WS_DK) + (size_t)b * T * 256; const bf16_t* DVb = c.w<bf16_t>(WS_DV) + (size_t)b * T * 256 + h * 64;
    f32x16 o[2];
    { bf16x8 qr[2];
#pragma unroll
      for (int d0 = 0; d0 < 2; ++d0) qr[d0] = *(const bf16x8*)(DQ + row * 256 + h * 64 + d0 * 16 + hi * 8);
      const fa::Src src{DKb + h * 64, 256, DVb, 256};
      fa::unit<2, 0, 8>(o, qr, src, 0, (q0 + 256) / 64, q0w, 0ull, c.lds, wid, lane); }
    o_spill(c, o);
    { bf16x8 qr[2];
#pragma unroll
      for (int d0 = 0; d0 < 2; ++d0) qr[d0] = *(const bf16x8*)(DQ + row * 256 + h * 64 + 32 + d0 * 16 + hi * 8);
      const fa::Src src{DKb + h * 64 + 32, 256, DVb, 256};
      fa::unit<2, 0, 8>(o, qr, src, 0, (q0 + 256) / 64, q0w, 0ull, c.lds, wid, lane); }
    const float lam = c.w<float>(WS_MISC)[512 + l], lam_init = c.w<float>(WS_MISC)[512 + NL + l];
    const float* sn = c.fin(22, 64, l); const float g0 = sn[r32] * (1.f - lam_init), g1 = sn[32 + r32] * (1.f - lam_init);
    bf16_t* OB = c.w<bf16_t>(WS_OBUF);
    f32x16 o1[2]; o_fill(c, o1);
    float ov[2][16];
#pragma unroll
    for (int r = 0; r < 16; ++r) {
        const float a0 = o1[0][r] - lam * o[0][r], a1 = o1[1][r] - lam * o[1][r];
        float ss = a0 * a0 + a1 * a1;
#pragma unroll
        for (int sft = 1; sft < 32; sft <<= 1) ss += __shfl_xor(ss, sft);
        const float rs = rsqrtf(ss * (1.f / 64.f) + EPS);
        ov[0][r] = a0 * rs * g0; ov[1][r] = a1 * rs * g1;
    }
    store_tile_wide(c.lds + ATT_STG_OFF, wid, ov, OB + ((size_t)b * T + q0w) * 1024 + 768 + h * 64, 1024, lane);
}
#ifndef ONLY_K
#define KEN(k) 1
#else
#define KEN(k) (ONLY_K == (k))
#endif
__device__ __forceinline__ Ctx make_ctx(const void* const* in, float* X, unsigned char* ws) {
    Ctx c; int t_ = threadIdx.x; asm volatile("" : "+v"(t_)); c.tid = t_; c.lane = t_ & 63; c.wave = __builtin_amdgcn_readfirstlane(t_ >> 6);
    extern __shared__ __attribute__((aligned(16))) unsigned char smem[];
    c.lds = (LAS unsigned char*)smem; c.G = gridDim.x; int b_ = blockIdx.x; asm volatile("" : "+s"(b_)); c.bid = b_;
    { __attribute__((address_space(1))) unsigned char* g_ = (__attribute__((address_space(1))) unsigned char*)ws; asm volatile("" : "+s"(g_)); c.ws = (unsigned char*)g_;
      __attribute__((address_space(1))) float* x_ = (__attribute__((address_space(1))) float*)X; asm volatile("" : "+s"(x_)); c.X = (float*)x_; } c.in = in;
    return c;
}
__device__ __forceinline__ int next_unit(const Ctx& c, int ctr_idx) {
    LAS int* slot = (LAS int*)(c.lds + LDS_BYTES - 64);
    __syncthreads();
    if (c.tid == 0) *slot = (int)atomicAdd(c.w<unsigned>(WS_CTL) + 64 * ctr_idx, 1u);
    __syncthreads();
    return *slot;
}
__device__ __forceinline__ void attn_phase(const Ctx& c, int l, int ph) {
    for (;;) {
        const int u = next_unit(c, ph); if (u >= 1024) break;
        const int qb = 15 - (u >> 6), j = u & 63;
#ifndef FA_ONLY
#define FA_ONLY 7
#endif
        const Ctx cu = make_ctx(c.in, c.X, c.ws);
        if (j < 24) { if (FA_ONLY & 1) mla_unit(cu, j / 6, j % 6, qb); }
        else if (j < 48) { if (FA_ONLY & 2) nsa_unit(cu, (j - 24) / 6, (j - 24) % 6, qb); }
        else { if (FA_ONLY & 4) diff_unit(cu, l, (j - 48) / 4, (j - 48) % 4, qb); }
    }
}
constexpr int CTL_PANEL_WORD0 = 4096;
__device__ __forceinline__ void final_fused(const Ctx& c, const pg8::StaticOrder& S) {
    unsigned* ctl = c.w<unsigned>(WS_CTL);
    asm volatile("s_waitcnt vmcnt(0)" ::: "memory");
    __syncthreads();
    if (c.tid == 0) {
        __builtin_amdgcn_fence(__ATOMIC_RELEASE, "agent"); asm volatile("s_waitcnt vmcnt(0)" ::: "memory");
        pg8::Unit u; for (int i = 0; S.next(i, u); ++i) __hip_atomic_fetch_add(ctl + CTL_PANEL_WORD0 + 64 * u.pm, 1u, __ATOMIC_RELAXED, __HIP_MEMORY_SCOPE_AGENT);
        for (int i = 0; S.next(i, u); ++i) { unsigned sp = 0;
            while (__hip_atomic_load(ctl + CTL_PANEL_WORD0 + 64 * u.pm, __ATOMIC_RELAXED, __HIP_MEMORY_SCOPE_AGENT) < 4u) { __builtin_amdgcn_s_sleep(1); if (++sp > (1u << 22)) break; } }
        __builtin_amdgcn_fence(__ATOMIC_ACQUIRE, "agent"); asm volatile("s_waitcnt vmcnt(0)" ::: "memory");
    }
    __syncthreads();
    const float* part = c.w<float>(WS_PART); const f32x4* gn = (const f32x4*)c.in[28] + c.lane;
    pg8::Unit u;
    f32x4 gg[4];
#pragma unroll
    for (int j = 0; j < 4; ++j) gg[j] = gn[64 * j];
    for (int i = 0; S.next(i, u); ++i)
#pragma unroll
        for (int half = 0; half < 2; ++half) {
            f32x4 v[4][4], pp[4][4];
#pragma unroll
            for (int q = 0; q < 4; ++q) { const int row = u.pm * 256 + u.pn * 64 + c.wave + 8 * (half * 4 + q); const f32x4* xr = (const f32x4*)(c.X + (size_t)row * D) + c.lane; const f32x4* p = (const f32x4*)(part + (size_t)row * 16);
#pragma unroll
                for (int j = 0; j < 4; ++j) { v[q][j] = xr[64 * j]; pp[q][j] = p[j]; } }
#pragma unroll
            for (int q = 0; q < 4; ++q) { const int row = u.pm * 256 + u.pn * 64 + c.wave + 8 * (half * 4 + q); f32x4* xr = (f32x4*)(c.X + (size_t)row * D) + c.lane;
                float sm = 0.f;
#pragma unroll
                for (int j = 0; j < 4; ++j) sm += (pp[q][j].x + pp[q][j].y) + (pp[q][j].z + pp[q][j].w);
                const float rs = rsqrtf(sm * (1.f / 1024.f) + EPS);
#pragma unroll
                for (int j = 0; j < 4; ++j) xr[64 * j] = v[q][j] * rs * gg[j]; }
        }
}
__device__ __forceinline__ void final_phase(const Ctx& c) {
    const int gw = c.bid * 8 + c.wave, NGW = c.G * 8, lane = c.lane; const float* part = c.w<float>(WS_PART); const f32x4* gn = (const f32x4*)c.in[28] + lane;
    for (int row = gw; row < M; row += NGW) {
        const float rs = rstd_from_part(part, row); f32x4* xr = (f32x4*)(c.X + (size_t)row * D) + lane;
#pragma unroll
        for (int j = 0; j < 4; ++j) { const f32x4 v = xr[64 * j], gg = gn[64 * j]; xr[64 * j] = v * rs * gg; }
    }
}

#define XB_TMO      128
#define XB_XCNT(j)  (256  + 64 * (j))
#define XB_XSUB(j)  (1280 + 64 * (j))
#define XB_XGEN(j)  (2304 + 64 * (j))
#define XB_TOP      3328
#define XB_TOPGEN   3392
#define XCD_BAR_WORDS 3456
#define XB_SPIN_CAP (1u << 20)
__device__ __forceinline__ unsigned xb_ld(unsigned* p)              { return __hip_atomic_load(p, __ATOMIC_RELAXED, __HIP_MEMORY_SCOPE_AGENT); }
__device__ __forceinline__ unsigned xb_add(unsigned* p, unsigned v) { return __hip_atomic_fetch_add(p, v, __ATOMIC_RELAXED, __HIP_MEMORY_SCOPE_AGENT); }
__device__ __forceinline__ unsigned xb_xcc_id() { return (unsigned)__builtin_amdgcn_s_getreg((3 << 11) | 20) & 0xFu; }
#define XB_SPIN(cond, bar) do { unsigned _sp = 0; while (cond) { __builtin_amdgcn_s_sleep(1); \
    if ((++_sp & 255u) == 0u) { if (xb_ld(&(bar)[XB_TMO])) break; if (_sp > XB_SPIN_CAP) { atomicAdd(&(bar)[XB_TMO], 1u); break; } } } } while (0)
struct XcdBarrier { unsigned* bar; unsigned x; volatile LAS unsigned* st; };
__device__ __forceinline__ XcdBarrier xcd_barrier_post(unsigned* bar, volatile LAS unsigned* st) {
    XcdBarrier b; b.bar = bar; b.x = xb_xcc_id(); b.st = st;
    if (threadIdx.x == 0) (void)xb_add(&bar[XB_XCNT(b.x)], 1u);
    return b;
}
__device__ __forceinline__ void xcd_barrier_complete(unsigned* bar, unsigned x, unsigned& nloc, unsigned& nx) {
    const unsigned G = gridDim.x * gridDim.y * gridDim.z;
    unsigned sum, cnt, mine, sp = 0u;
    for (;;) {
        sum = 0u; cnt = 0u; mine = 0u;
        unsigned cv[16];
#pragma unroll
        for (unsigned j = 0; j < 16; ++j) cv[j] = xb_ld(&bar[XB_XCNT(j)]);
#pragma unroll
        for (unsigned j = 0; j < 16; ++j) { const unsigned c = cv[j]; sum += c; cnt += (c > 0u) ? 1u : 0u; mine = (j == x) ? c : mine; }
        if (sum == G) break;
        __builtin_amdgcn_s_sleep(1);
        if ((++sp & 255u) == 0u) { if (xb_ld(&bar[XB_TMO])) break; if (sp > XB_SPIN_CAP) { atomicAdd(&bar[XB_TMO], 1u); break; } }
    }
    nloc = mine > 0u ? mine : 1u; nx = cnt > 0u ? cnt : 1u;
}
__device__ __forceinline__ void xcd_barrier(const XcdBarrier& b) {
    asm volatile("s_waitcnt vmcnt(0)" ::: "memory");
    __syncthreads();
    if (threadIdx.x == 0) {
        unsigned* bar = b.bar;
        __builtin_amdgcn_s_waitcnt(0);
        unsigned nloc = b.st[0], nx = b.st[1];
        if (nloc == 0u) { xcd_barrier_complete(bar, b.x, nloc, nx); b.st[0] = nloc; b.st[1] = nx; }
        const unsigned old = xb_add(&bar[XB_XSUB(b.x)], 1u);
        const unsigned gen = old / nloc;
        if (old + 1u == (gen + 1u) * nloc) {
            __builtin_amdgcn_fence(__ATOMIC_RELEASE, "agent");
            asm volatile("s_waitcnt vmcnt(0)" ::: "memory");
            const unsigned og = xb_add(&bar[XB_TOP], 1u);
            const unsigned tg = og / nx;
            if (og + 1u == (tg + 1u) * nx) xb_add(&bar[XB_TOPGEN], 1u);
            else XB_SPIN(xb_ld(&bar[XB_TOPGEN]) == tg, bar);
            __builtin_amdgcn_fence(__ATOMIC_ACQUIRE, "agent");
            xb_add(&bar[XB_XGEN(b.x)], 1u);
            asm volatile("s_waitcnt vmcnt(0)" ::: "memory");
        } else {
            XB_SPIN(xb_ld(&bar[XB_XGEN(b.x)]) == gen, bar);
            __builtin_amdgcn_fence(__ATOMIC_ACQUIRE, "agent");
            asm volatile("s_waitcnt vmcnt(0)" ::: "memory");
        }
    }
    __syncthreads();
}
constexpr size_t CTL_BAR_OFF = 32 * KiB;

constexpr int N_PHASES = 24;
__device__ __forceinline__ bool phase_empty(int ph) { return ph == 1 || ph == 12; }
__device__ __forceinline__ void fill_rstab(const Ctx& c, const pg8::StaticOrder& S) {
    LAS float* tab = (LAS float*)(c.lds + pg8::RSTAB_OFF); const float* part = c.w<float>(WS_PART);
    bool okv[4]; f32x4 pv_[4][4];
#pragma unroll
    for (int q = 0; q < 4; ++q) { const int i = (c.tid >> 8) + 2 * q; pg8::Unit u; u.pm = 0; u.pn = 0; okv[q] = S.next(i, u);
        const f32x4* p = (const f32x4*)(part + (size_t)u.pm * 256 * 16) + (c.tid & 255);
#pragma unroll
        for (int k = 0; k < 4; ++k) pv_[q][k] = p[256 * k]; }
#pragma unroll
    for (int q = 0; q < 4; ++q) { const int i = (c.tid >> 8) + 2 * q;
#pragma unroll
        for (int k = 0; k < 4; ++k) { const f32x4 a = pv_[q][k]; float sm = (a.x + a.y) + (a.z + a.w);
            sm = WS_DPP_ADD(sm, 0xB1); sm = WS_DPP_ADD(sm, 0x4E);
            if (okv[q] && (c.tid & 3) == 0) tab[i * 256 + (((c.tid & 255) + 256 * k) >> 2)] = rsqrtf(sm * (1.f / 1024.f) + EPS); } }
    __syncthreads();
}
__device__ __forceinline__ void run_phase(const void* const* in_, float* X_, unsigned char* ws_, int ph, int rep) {
    const Ctx c = make_ctx(in_, X_, ws_);
    const int l = (ph - 1) / 11, k = (ph - 1) % 11;
    LAS unsigned char* lds = c.lds;
    switch (k) {
    case 1: case 9: if (KEN(1)) { pg8::Gemm g{c.w<bf16_t>(WS_XB), c.w<bf16_t>(k == 1 ? WS_W1A : WS_W2A), D, D, D}; pg8::StaticOrder S; S.init(M, 2 * FF, c.G, c.bid);
                      if (rep == 0 && c.G == 256) { if (k == 1) convert_set(c, l, 2, 128, 128); else if (l + 1 < NL) convert_set(c, l + 1, 0, 128, 128); }
                      fill_rstab(c, S);
                      pg8::EpiSwiglu E{c.w<bf16_t>(WS_HFF), c.w<float>(WS_PART), (const LAS float*)(lds + pg8::RSTAB_OFF)}; pg8::gemm_phase(lds, c.tid, g, S, E); } break;
    case 2: case 10: if (KEN(2)) { pg8::Gemm g{c.w<bf16_t>(WS_HFF), c.w<bf16_t>(k == 2 ? WS_W1D : WS_W2D), FF, FF, FF}; pg8::StaticOrder S; S.init(M, D, c.G, c.bid);
                       const bool fin_ = (l == NL - 1 && k == 10 && rep == 0);
                       pg8::EpiResid E{c.X, c.w<bf16_t>(WS_XB), c.w<float>(WS_PART), rep ? 0.f : 0.5f, fin_ ? (c.G == 256 ? 2 : 1) : 0,
                                       c.w<unsigned>(WS_CTL) + CTL_PANEL_WORD0, (const float*)c.in[28], (LAS float*)(lds + pg8::RSTAB_OFF)}; pg8::gemm_phase(lds, c.tid, g, S, E);
                       if (fin_ && c.G != 256) final_fused(c, S); } break;
    case 3: if (KEN(3)) { pg8::Gemm g{c.w<bf16_t>(WS_XB), c.w<bf16_t>(WS_WIN), D, D, D}; pg8::StaticOrder S; S.init(M, HW, c.G, c.bid);
              if (rep == 0) convert_set(c, l, 1, 64, c.G - 64);
              fill_rstab(c, S);
              pg8::EpiRoute E{c.ws, c.w<float>(WS_PART), (const LAS float*)(lds + pg8::RSTAB_OFF)}; pg8::gemm_phase(lds, c.tid, g, S, E); } break;
    case 4: if (KEN(4)) prep_phase(c); break;
    case 5: if (KEN(5)) { pg8::Gemm g{c.w<bf16_t>(WS_OCMP), c.w<bf16_t>(WS_WMLA), 384, 384, 384}; pg8::StaticOrder S; S.init(M, 1536, c.G, c.bid);
              pg8::EpiScale<1> E{c.w<bf16_t>(WS_QKV), 1536, c.w<float>(WS_RSQ), c.w<float>(WS_RSKV), nullptr}; pg8::gemm_phase(lds, c.tid, g, S, E);
              }
              if (KEN(50)) { __syncthreads();
              for (int u = c.G - 1 - c.bid; u < 128; u += c.G) compress_unit(c, l, u); } break;
    case 6: if (KEN(6)) { for (int u = c.bid; u < 256; u += c.G) cmp_unit(c, u);
              if (rep == 0 && c.G != 256 && l + 1 < NL) { convert_set(c, l + 1, 0, 0, c.G); convert_set(c, l + 1, 2, 0, c.G); } } break;
    case 7: if (KEN(7)) attn_phase(c, l, ph + 32 * rep); break;
    case 8: if (KEN(8)) { pg8::Gemm g{c.w<bf16_t>(WS_OBUF), c.w<bf16_t>(WS_WOUT), D, D, D}; pg8::StaticOrder S; S.init(M, D, c.G, c.bid);
              pg8::EpiResid E{c.X, c.w<bf16_t>(WS_XB), c.w<float>(WS_PART), rep ? 0.f : 1.0f, 0, nullptr, nullptr, nullptr}; pg8::gemm_phase(lds, c.tid, g, S, E); } break;
    }
}
__global__ void __launch_bounds__(512, 2) fwd_kernel(Args a) {
    extern __shared__ __attribute__((aligned(16))) unsigned char smem[];
    cg::grid_group grid = cg::this_grid();
    volatile LAS unsigned* bst = (volatile LAS unsigned*)((LAS unsigned char*)smem + LDS_BYTES - 128);
    if (threadIdx.x < 2) bst[threadIdx.x] = 0u;
    __syncthreads();
    const XcdBarrier bar = xcd_barrier_post((unsigned*)(a.ws + WS_CTL + CTL_BAR_OFF), bst);
    int lo = a.ph_lo, hi = a.ph_hi;
    if (lo < 0) grid.sync();
    if (lo == 0) { { const Ctx c = make_ctx(a.in, a.out, a.ws); prologue(c); } lo = 1; if (lo < hi) xcd_barrier(bar); }
    const bool do_final = false; if (hi > N_PHASES - 1) hi = N_PHASES - 1;
    for (int ph = lo; ph < hi; ++ph) {
        if (phase_empty(ph)) continue;
        int reps = 1;
#ifdef PROBE_REP
        { const int k_ = (ph - 1) % 11, kk_ = (k_ == 9) ? 1 : (k_ == 10) ? 2 : k_; if (kk_ == PROBE_REP) reps = 2; }
#endif
        for (int rep = reps - 1; rep >= 0; --rep) run_phase(a.in, a.out, a.ws, ph, rep);
        if (ph + 1 < hi || do_final) { xcd_barrier(bar);
#ifdef PROBE_BAR
            xcd_barrier(bar);
#endif
        }
    }
    if (do_final) { const Ctx c = make_ctx(a.in, a.out, a.ws); final_phase(c); }
}

extern "C" void kernel_launch(void* const* d_in, const int* in_sizes, int n_in, void* d_out, int out_size, void* d_ws, size_t ws_size, hipStream_t stream) {
    static int grid = 0;
    if (grid == 0) {
        if (n_in != 29 || out_size != M * D || ws_size < WS_END) { fprintf(stderr, "kernel_launch: unexpected shapes (n_in %d, out %d, ws %zu)\n", n_in, out_size, ws_size); grid = -1; return; }
        int dev = 0, cus = 0, per_cu = 0;
        hipGetDevice(&dev); hipDeviceGetAttribute(&cus, hipDeviceAttributeMultiprocessorCount, dev);
        hipFuncSetAttribute((const void*)fwd_kernel, hipFuncAttributeMaxDynamicSharedMemorySize, LDS_BYTES);
        hipOccupancyMaxActiveBlocksPerMultiprocessor(&per_cu, (const void*)fwd_kernel, 512, LDS_BYTES);
        if (per_cu < 1) { fprintf(stderr, "kernel_launch: occupancy query says %d blocks/CU\n", per_cu); per_cu = 1; }
        (void)hipGetLastError();
        grid = cus * per_cu;
        fprintf(stderr, "kernel_launch: grid %d (cus %d x %d)\n", grid, cus, per_cu);
    }
    if (grid < 0) return;
    hipMemsetAsync((char*)d_ws + WS_CTL, 0, CTL_BYTES, stream);
    Args a{};
    for (int i = 0; i < 29; ++i) a.in[i] = d_in[i];
    a.out = (float*)d_out; a.ws = (unsigned char*)d_ws;
#if MK_SPLIT
    for (int ph = 0; ph < N_PHASES; ++ph) {
        if (ph == 1 || ph == 12) continue;
        a.ph_lo = ph; a.ph_hi = ph + 1; void* args[] = {&a};
        hipError_t e = hipLaunchCooperativeKernel((const void*)fwd_kernel, dim3(grid), dim3(512), args, LDS_BYTES, stream);
        if (e != hipSuccess) { fprintf(stderr, "launch failed (phase %d): %s\n", ph, hipGetErrorString(e)); return; }
    }
#else
    a.ph_lo = 0; a.ph_hi = N_PHASES; void* args[] = {&a};
    hipError_t e = hipLaunchCooperativeKernel((const void*)fwd_kernel, dim3(grid), dim3(512), args, LDS_BYTES, stream);
    if (e != hipSuccess) fprintf(stderr, "cooperative launch failed: %s (grid %d)\n", hipGetErrorString(e), grid);
#endif
}
```
